# Optimizing an MI355X kernel written in HIP

```python
import jax, jax.numpy as jnp
from jax import lax
import numpy as np

D_MODEL = 1024
BATCH = 2
SEQ = 8192
DEPTH = 1
DEC_BATCH = 8
DEC_SEQ = 16
PAST_LEN = 1024

CHUNK = 64
Q_BLOCK = 128
N_HEADS = 8
QK_NOPE = 64
QK_ROPE = 32
V_HEAD = 64
Q_LORA = 256
KV_LORA = 128
MLA_WIDTH = N_HEADS * V_HEAD
CONV_WIDTH = 512
CONV_K = 3
ROPE_BASE = 10000.0
EPS = 1e-6
SM_SCALE = (QK_NOPE + QK_ROPE) ** -0.5
NEG_INF = -1e30
IN_COLS = Q_LORA + KV_LORA + QK_ROPE + MLA_WIDTH + 4 * CONV_WIDTH + 2 * D_MODEL

kernel_name = "hybrid_mla_shortconv_stream_step"


def _rms_norm(x, g):
    xf = x.astype(jnp.float32)
    y = xf * lax.rsqrt(jnp.mean(xf * xf, axis=-1, keepdims=True) + EPS)
    return (y * g.astype(jnp.float32)).astype(x.dtype)


def _rope(x, pos):
    half = QK_ROPE // 2
    inv = ROPE_BASE ** (-jnp.arange(half, dtype=jnp.float32) / half)
    ang = pos.astype(jnp.float32)[:, None] * inv[None, :]
    cos, sin = jnp.cos(ang), jnp.sin(ang)
    if x.ndim == 4:
        cos, sin = cos[:, None, :], sin[:, None, :]
    xf = x.astype(jnp.float32)
    x1, x2 = xf[..., :half], xf[..., half:]
    return jnp.concatenate([x1 * cos - x2 * sin, x2 * cos + x1 * sin], axis=-1).astype(x.dtype)


def _split_cols(p):
    sizes = (Q_LORA, KV_LORA, QK_ROPE, MLA_WIDTH, CONV_WIDTH, CONV_WIDTH, CONV_WIDTH, CONV_WIDTH, D_MODEL, D_MODEL)
    out, start = [], 0
    for s in sizes:
        out.append(p[..., start:start + s])
        start += s
    return out


def _attend(q_abs, q_pe, c_kv, k_pe, qpos, kpos):
    s = (jnp.einsum('bthc,bsc->bhts', q_abs, c_kv)
         + jnp.einsum('bthr,bsr->bhts', q_pe, k_pe)).astype(jnp.float32) * SM_SCALE
    visible = (kpos[None, :] // CHUNK) <= (qpos[:, None] // CHUNK)
    s = jnp.where(visible[None, None], s, NEG_INF)
    p = jax.nn.softmax(s, axis=-1).astype(c_kv.dtype)
    return jnp.einsum('bhts,bsc->bthc', p, c_kv)


def _layer(x, pos, past_ckv, past_kpe, past_conv, blocked,
           pre_g, w_in, q_g, w_uq, kv_g, w_uk, w_uv, w_o_mla, conv_w, w_o_conv, w_out, post_g):
    b, t, _ = x.shape
    h = _rms_norm(x, pre_g)
    q_lat, kv_lat, k_rope, g_mla, c_b, c_c, c_x, g_conv, m_mla, m_conv = _split_cols(h @ w_in)

    q = (_rms_norm(q_lat, q_g) @ w_uq).reshape(b, t, N_HEADS, QK_NOPE + QK_ROPE)
    q_nope = q[..., :QK_NOPE]
    q_pe = _rope(q[..., QK_NOPE:], pos)
    c_kv = _rms_norm(kv_lat, kv_g)
    k_pe = _rope(k_rope, pos)
    q_abs = jnp.einsum('bthd,chd->bthc', q_nope, w_uk)
    if past_ckv is None:
        keys_c, keys_r, kpos = c_kv, k_pe, pos
    else:
        keys_c = jnp.concatenate([past_ckv, c_kv], axis=1)
        keys_r = jnp.concatenate([past_kpe, k_pe], axis=1)
        kpos = jnp.concatenate([jnp.arange(past_ckv.shape[1], dtype=jnp.int32), pos])
    if blocked:
        nb = t // Q_BLOCK

        def to_blocks(a):
            return jnp.moveaxis(a.reshape((b, nb, Q_BLOCK) + a.shape[2:]), 1, 0)

        o_lat = lax.map(lambda xs: _attend(xs[0], xs[1], keys_c, keys_r, xs[2], kpos),
                        (to_blocks(q_abs), to_blocks(q_pe), pos.reshape(nb, Q_BLOCK)))
        o_lat = jnp.moveaxis(o_lat, 0, 1).reshape(b, t, N_HEADS, KV_LORA)
    else:
        o_lat = _attend(q_abs, q_pe, keys_c, keys_r, pos, kpos)
    o = jnp.einsum('bthc,chd->bthd', o_lat, w_uv).reshape(b, t, MLA_WIDTH)
    branch_a = (o * jax.nn.silu(g_mla)) @ w_o_mla

    u = c_c * c_x
    u_ext = jnp.concatenate([past_conv, u], axis=1)
    conv = conv_w[0] * u_ext[:, 0:t]
    for k in range(1, CONV_K):
        conv = conv + conv_w[k] * u_ext[:, k:k + t]
    branch_b = (c_b * conv * jax.nn.silu(g_conv)) @ w_o_conv

    merged = jax.nn.sigmoid(m_mla) * branch_a + jax.nn.sigmoid(m_conv) * branch_b
    y = x + _rms_norm(merged @ w_out, post_g)
    return y, c_kv, k_pe, u_ext[:, -(CONV_K - 1):]


def setup_inputs(seed: int = 0) -> dict:
    key = jax.random.key(seed)
    ks = jax.random.split(key, 17)
    f32 = jnp.float32
    nrm = lambda k, shape, s=1.0: jax.random.normal(k, shape, f32) * s
    gain = lambda k, n: 1.0 + 0.01 * jax.random.normal(k, (DEPTH, n), f32)
    return {
        "x_prompt": nrm(ks[0], (BATCH, SEQ, D_MODEL)),
        "x_sample": nrm(ks[1], (DEC_BATCH, DEC_SEQ, D_MODEL)),
        "cache_kv_latent": nrm(ks[2], (DEPTH, DEC_BATCH, PAST_LEN, KV_LORA)),
        "cache_k_rope": nrm(ks[3], (DEPTH, DEC_BATCH, PAST_LEN, QK_ROPE)),
        "state_conv": nrm(ks[4], (DEPTH, DEC_BATCH, CONV_K - 1, CONV_WIDTH)),
        "pre_norm": gain(ks[5], D_MODEL),
        "w_in": nrm(ks[6], (DEPTH, D_MODEL, IN_COLS), D_MODEL ** -0.5),
        "q_norm": gain(ks[7], Q_LORA),
        "w_uq": nrm(ks[8], (DEPTH, Q_LORA, N_HEADS * (QK_NOPE + QK_ROPE)), Q_LORA ** -0.5),
        "kv_norm": gain(ks[9], KV_LORA),
        "w_uk": nrm(ks[10], (DEPTH, KV_LORA, N_HEADS, QK_NOPE), KV_LORA ** -0.5),
        "w_uv": nrm(ks[11], (DEPTH, KV_LORA, N_HEADS, V_HEAD), KV_LORA ** -0.5),
        "w_o_mla": nrm(ks[12], (DEPTH, MLA_WIDTH, D_MODEL), MLA_WIDTH ** -0.5),
        "conv_w": nrm(ks[13], (DEPTH, CONV_K, CONV_WIDTH), CONV_K ** -0.5),
        "w_o_conv": nrm(ks[14], (DEPTH, CONV_WIDTH, D_MODEL), CONV_WIDTH ** -0.5),
        "w_out": nrm(ks[15], (DEPTH, D_MODEL, D_MODEL), D_MODEL ** -0.5),
        "post_norm": gain(ks[16], D_MODEL),
    }


def reference(x_prompt, x_sample, cache_kv_latent, cache_k_rope, state_conv,
              pre_norm, w_in, q_norm, w_uq, kv_norm, w_uk, w_uv, w_o_mla, conv_w, w_o_conv, w_out, post_norm):
    yp, ys = x_prompt, x_sample
    pos_p = jnp.arange(x_prompt.shape[1], dtype=jnp.int32)
    pos_s = cache_kv_latent.shape[2] + jnp.arange(x_sample.shape[1], dtype=jnp.int32)
    ckv_p, kpe_p, cv_p, ckv_s, kpe_s, cv_s = [], [], [], [], [], []
    for l in range(DEPTH):
        w = (pre_norm[l], w_in[l], q_norm[l], w_uq[l], kv_norm[l], w_uk[l], w_uv[l],
             w_o_mla[l], conv_w[l], w_o_conv[l], w_out[l], post_norm[l])
        pad = jnp.zeros((yp.shape[0], CONV_K - 1, CONV_WIDTH), yp.dtype)
        yp, a, r, c = _layer(yp, pos_p, None, None, pad, True, *w)
        ckv_p.append(a); kpe_p.append(r); cv_p.append(c)
        ys, a, r, c = _layer(ys, pos_s, cache_kv_latent[l], cache_k_rope[l], state_conv[l], False, *w)
        ckv_s.append(a); kpe_s.append(r); cv_s.append(c)
    return (yp, ys, jnp.stack(ckv_p), jnp.stack(kpe_p), jnp.stack(cv_p),
            jnp.stack(ckv_s), jnp.stack(kpe_s), jnp.stack(cv_s))
```

```cpp
#include <hip/hip_runtime.h>
#include <hip/hip_cooperative_groups.h>
#include <cstdio>
namespace cg = cooperative_groups;

#ifndef PHASE_MASK
#define PHASE_MASK 127
#endif
#ifndef ONE_LAUNCH
#define ONE_LAUNCH 1
#endif
#ifndef PROBE_REPEAT
#define PROBE_REPEAT 0
#endif

#define DI __device__ __forceinline__
typedef unsigned short u16;
typedef __attribute__((ext_vector_type(8))) short bf16x8;
typedef __attribute__((ext_vector_type(4))) short s16x4;
typedef __attribute__((ext_vector_type(16))) float f32x16;
typedef __attribute__((ext_vector_type(4))) float f32x4;
typedef __attribute__((ext_vector_type(4))) unsigned u32x4;
typedef __attribute__((ext_vector_type(2))) unsigned u32x2;
typedef __attribute__((ext_vector_type(2))) __bf16 bf2_t;
typedef __attribute__((ext_vector_type(2))) float f2_t;
#define MFMA(a, b, c) __builtin_amdgcn_mfma_f32_32x32x16_bf16((a), (b), (c), 0, 0, 0)

constexpr int NP = 16384, NS = 128, NR = NP + NS, NRP = 16640;
constexpr int SEQ = 8192, PAST = 1024, DSEQ = 16, KSROWS = 1088;
constexpr int INC = 5024;
constexpr float EPS = 1e-6f;
constexpr float QSCALE = 0.10206207261596575f * 1.4426950408889634f;
constexpr int EPI_LD = 260;
constexpr int SIDE_OFF = 128 * EPI_LD * 4;
constexpr int LDS_BYTES = 128 * EPI_LD * 4 + 512;

constexpr size_t SZ_ROWS1024 = (size_t)NRP * 1024 * 2;
constexpr size_t SZ_ROWS512 = (size_t)NRP * 512 * 2;
constexpr size_t OFF_XB = 0;
constexpr size_t OFF_QP = OFF_XB + SZ_ROWS1024;
constexpr size_t OFF_WIN = OFF_QP + (size_t)NRP * 1280 * 2;
constexpr size_t OFF_WQ = OFF_WIN + (size_t)5120 * 1024 * 2;
constexpr size_t OFF_WOA = OFF_WQ + (size_t)1280 * 256 * 2;
constexpr size_t OFF_WOB = OFF_WOA + (size_t)1024 * 512 * 2;
constexpr size_t OFF_WOUT = OFF_WOB + (size_t)1024 * 512 * 2;
constexpr size_t OFF_WUV = OFF_WOUT + (size_t)1024 * 1024 * 2;
constexpr size_t OFF_QLAT = OFF_WUV + 131072;
constexpr size_t OFF_KP = OFF_QLAT + (size_t)NRP * 256 * 2;
constexpr size_t OFF_KS = OFF_KP + (size_t)2 * SEQ * 160 * 2;
constexpr size_t OFF_SG = OFF_KS + (size_t)8 * KSROWS * 160 * 2;
constexpr size_t OFF_U = OFF_SG + SZ_ROWS512;
constexpr size_t OFF_V = OFF_U + SZ_ROWS512;
constexpr size_t OFF_CB = OFF_V + SZ_ROWS512;
constexpr size_t OFF_SA = OFF_CB + SZ_ROWS512;
constexpr size_t OFF_SB = OFF_SA + SZ_ROWS1024;
constexpr size_t OFF_RSTDX = OFF_SB + SZ_ROWS1024;
constexpr size_t OFF_SSQQ = OFF_RSTDX + (size_t)NRP * 4;
constexpr size_t OFF_SSQZ = OFF_SSQQ + (size_t)NRP * 4;
constexpr size_t OFF_ROPE = OFF_SSQZ + (size_t)NRP * 4;
constexpr size_t OFF_ZS = OFF_ROPE + (size_t)SEQ * 32 * 4;
constexpr size_t OFF_BAR = OFF_ZS + (size_t)NS * 1024 * 4;
constexpr size_t BAR_BYTES = 16384;
constexpr size_t WS_END = OFF_BAR + BAR_BYTES;

constexpr size_t O_YP = 0;
constexpr size_t O_YS = O_YP + (size_t)NP * 1024;
constexpr size_t O_CKVP = O_YS + (size_t)NS * 1024;
constexpr size_t O_KPEP = O_CKVP + (size_t)NP * 128;
constexpr size_t O_CONVP = O_KPEP + (size_t)NP * 32;
constexpr size_t O_CKVS = O_CONVP + (size_t)2 * 2 * 512;
constexpr size_t O_KPES = O_CKVS + (size_t)NS * 128;
constexpr size_t O_CONVS = O_KPES + (size_t)NS * 32;

struct Params {
  const float* in[17];
  float* out;
  char* ws;
  int ph_lo, ph_hi;
  short sched[256][4];
};

DI int get_tid() { int t = threadIdx.x; asm volatile("" : "+v"(t)); return t; }
DI float bf2f(u16 v) { return __uint_as_float(((unsigned)v) << 16); }
DI unsigned pack2(float a, float b) {
  f2_t v = {a, b};
  bf2_t r = __builtin_convertvector(v, bf2_t);
  return __builtin_bit_cast(unsigned, r);
}
DI u16 f2bf(float a) { return (u16)(pack2(a, 0.f) & 0xffffu); }
DI int crow(int i, int h) { return (i & 3) + 8 * (i >> 2) + 4 * h; }
DI float wave_sum(float v) {
  v += __shfl_xor(v, 1); v += __shfl_xor(v, 2); v += __shfl_xor(v, 4);
  v += __shfl_xor(v, 8); v += __shfl_xor(v, 16); v += __shfl_xor(v, 32);
  return v;
}
DI float half_sum(float v) {
  v += __shfl_xor(v, 1); v += __shfl_xor(v, 2); v += __shfl_xor(v, 4);
  v += __shfl_xor(v, 8); v += __shfl_xor(v, 16);
  return v;
}
DI float sigm_f(float v) { return __builtin_amdgcn_rcpf(1.f + __builtin_amdgcn_exp2f(-1.4426950408889634f * v)); }
DI float silu_f(float v) { return v * sigm_f(v); }
DI int row_pos(int row) { return row < NP ? (row & (SEQ - 1)) : PAST + ((row - NP) & (DSEQ - 1)); }
DI void rope_cs(int pos, int i, float& c, float& s) {
  const int a = i & 3, b = i >> 2;
  double base = a == 0 ? 1.0 : (a == 1 ? 0.5623413251903491 : (a == 2 ? 0.31622776601683794 : 0.1778279410038923));
  double sc = b == 0 ? 1.0 : (b == 1 ? 0.1 : (b == 2 ? 0.01 : 0.001));
  const float invf = (float)(base * sc);
  double rev = (double)pos * (double)invf * 0.15915494309189535;
  rev = rev - floor(rev);
  const float r = (float)rev;
  c = __builtin_amdgcn_cosf(r);
  s = __builtin_amdgcn_sinf(r);
}
DI u32x4 pack8(float a0, float a1, float a2, float a3, float a4, float a5, float a6, float a7) {
  u32x4 o = {pack2(a0, a1), pack2(a2, a3), pack2(a4, a5), pack2(a6, a7)};
  return o;
}
DI bf16x8 pack_step(const f32x16& x, int s) {
  u32x4 o;
  if (s == 0) o = pack8(x[0], x[1], x[2], x[3], x[4], x[5], x[6], x[7]);
  else o = pack8(x[8], x[9], x[10], x[11], x[12], x[13], x[14], x[15]);
  return __builtin_bit_cast(bf16x8, o);
}

DI int colmap(int n2) {
  if (n2 < 256) return n2;
  if (n2 < 512) { int j = n2 - 256; return j < 160 ? 256 + j : -1; }
  if (n2 < 1024) return 416 + (n2 - 512);
  if (n2 < 3072) { int g = (n2 - 1024) >> 7, w = (n2 - 1024) & 127; return 928 + (w >> 5) * 512 + g * 32 + (w & 31); }
  if (n2 < 4096) return 2976 + (n2 - 3072);
  return 4000 + (n2 - 4096);
}

DI void transpose_w(const float* __restrict__ src, int Ks, int Ns, u16* __restrict__ dst, int gtid, int nth) {
  const int total = Ns * (Ks >> 3);
  for (int idx = gtid; idx < total; idx += nth) {
    const int n = idx % Ns, k8 = idx / Ns;
    float v[8];
#pragma unroll
    for (int j = 0; j < 8; ++j) v[j] = src[(size_t)(k8 * 8 + j) * Ns + n];
    *(u32x4*)(dst + (size_t)n * Ks + k8 * 8) = pack8(v[0], v[1], v[2], v[3], v[4], v[5], v[6], v[7]);
  }
}

DI void prep_late(const Params& p, int gtid, int nth) {
  char* ws = p.ws;
  {
    const float* wuq = p.in[8];
    const float* wuk = p.in[10];
    const float* qg = p.in[7];
    u16* dst = (u16*)(ws + OFF_WQ);
    for (int idx = gtid; idx < 1280 * 256; idx += nth) {
      const int n2 = idx >> 8, k = idx & 255;
      const int hd = n2 / 160, j = n2 % 160;
      float val;
      if (j < 128) {
        const float* a = wuq + (size_t)k * 768 + hd * 96;
        const float* b = wuk + (size_t)(j * 8 + hd) * 64;
        float s = 0.f;
        for (int d = 0; d < 64; ++d) s += a[d] * b[d];
        val = s;
      } else {
        val = wuq[(size_t)k * 768 + hd * 96 + 64 + (j - 128)];
      }
      dst[idx] = f2bf(val * qg[k] * QSCALE);
    }
  }
  transpose_w(p.in[12], 512, 1024, (u16*)(ws + OFF_WOA), gtid, nth);
  transpose_w(p.in[14], 512, 1024, (u16*)(ws + OFF_WOB), gtid, nth);
  transpose_w(p.in[15], 1024, 1024, (u16*)(ws + OFF_WOUT), gtid, nth);
  {
    const float* wuv = p.in[11];
    u16* dst = (u16*)(ws + OFF_WUV);
    for (int idx = gtid; idx < 65536; idx += nth) {
      const int j = idx & 7, ln = (idx >> 3) & 63, s = (idx >> 9) & 1, dt = (idx >> 10) & 3, mt = (idx >> 12) & 1, hd = idx >> 13;
      const int col = 32 * mt + (ln & 31);
      const int c = 32 * dt + 16 * s + 8 * (j >> 2) + 4 * (ln >> 5) + (j & 3);
      dst[idx] = f2bf(wuv[(size_t)(c * 8 + hd) * 64 + col]);
    }
  }
  {
    const float* ckv = p.in[2];
    const float* ckr = p.in[3];
    u16* dst = (u16*)(ws + OFF_KS);
    for (int idx = gtid; idx < 8 * KSROWS * 20; idx += nth) {
      const int ch = idx % 20, r = (idx / 20) % KSROWS, b = idx / (20 * KSROWS);
      u32x4 o = {0u, 0u, 0u, 0u};
      if (r < PAST) {
        const float* src = ch < 16 ? ckv + ((size_t)(b * PAST + r) * 128 + ch * 8) : ckr + ((size_t)(b * PAST + r) * 32 + (ch - 16) * 8);
        const f32x4 v0 = *(const f32x4*)src, v1 = *(const f32x4*)(src + 4);
        o = pack8(v0[0], v0[1], v0[2], v0[3], v1[0], v1[1], v1[2], v1[3]);
      } else if (r < PAST + DSEQ) continue;
      *(u32x4*)(dst + (size_t)(b * KSROWS + r) * 160 + ch * 8) = o;
    }
  }
}

DI void phase0(const Params& p) {
  const int tid = get_tid(), lane = tid & 63, wave = tid >> 6;
  const int nblk = gridDim.x, gtid = blockIdx.x * 512 + tid, nth = nblk * 512;
  char* ws = p.ws;
  {
    u16* xb = (u16*)(ws + OFF_XB);
    float* rstdx = (float*)(ws + OFF_RSTDX);
    for (int row = blockIdx.x * 8 + wave; row < NRP; row += nblk * 8) {
      u16* dst = xb + (size_t)row * 1024;
      if (row < NR) {
        const float* src = row < NP ? p.in[0] + (size_t)row * 1024 : p.in[1] + (size_t)(row - NP) * 1024;
        float ss = 0.f;
#pragma unroll
        for (int i = 0; i < 4; ++i) {
          const f32x4 v = *(const f32x4*)(src + (i * 64 + lane) * 4);
          ss += v[0] * v[0] + v[1] * v[1] + v[2] * v[2] + v[3] * v[3];
          u32x2 o = {pack2(v[0], v[1]), pack2(v[2], v[3])};
          *(u32x2*)(dst + (i * 64 + lane) * 4) = o;
        }
        ss = wave_sum(ss);
        if (lane == 0) rstdx[row] = rsqrtf(ss * (1.f / 1024.f) + EPS);
      } else {
#pragma unroll
        for (int i = 0; i < 4; ++i) { u32x2 o = {0u, 0u}; *(u32x2*)(dst + (i * 64 + lane) * 4) = o; }
        if (lane == 0) rstdx[row] = 0.f;
      }
    }
  }
  {
    const float* w = p.in[6];
    const float* g = p.in[5];
    u16* dst = (u16*)(ws + OFF_WIN);
    for (int idx = gtid; idx < 5120 * 128; idx += nth) {
      const int n2 = idx % 5120, k8 = idx / 5120;
      const int n = colmap(n2);
      u32x4 o = {0u, 0u, 0u, 0u};
      if (n >= 0) {
        float v[8];
#pragma unroll
        for (int j = 0; j < 8; ++j) v[j] = w[(size_t)(k8 * 8 + j) * INC + n] * g[k8 * 8 + j];
        o = pack8(v[0], v[1], v[2], v[3], v[4], v[5], v[6], v[7]);
      }
      *(u32x4*)(dst + (size_t)n2 * 1024 + k8 * 8) = o;
    }
  }
  {
    float* tab = (float*)(ws + OFF_ROPE);
    for (int idx = gtid; idx < SEQ * 16; idx += nth) {
      float c, sn;
      rope_cs(idx >> 4, idx & 15, c, sn);
      tab[(idx >> 4) * 32 + (idx & 15)] = c;
      tab[(idx >> 4) * 32 + 16 + (idx & 15)] = sn;
    }
  }
  {
    float* a = (float*)(ws + OFF_SSQQ);
    float* b = (float*)(ws + OFF_SSQZ);
    for (int idx = gtid; idx < NRP; idx += nth) { a[idx] = 0.f; b[idx] = 0.f; }
    f32x4* zs = (f32x4*)(ws + OFF_ZS);
    const f32x4 z4 = {0.f, 0.f, 0.f, 0.f};
    for (int idx = gtid; idx < NS * 256; idx += nth) zs[idx] = z4;
  }
}

typedef f32x4 Acc8[2][2][4][2];
#define LDSP(x) ((__attribute__((address_space(3))) unsigned*)(x))
DI int lds_byte8(int r, int c) {
  const int st = (r >> 4) * 2 + (c >> 5), rr = r & 15, cc = c & 31, ob = rr * 64 + cc * 2;
  return st * 1024 + (ob ^ (((ob >> 9) & 1) << 5));
}
DI void stage_rc8(int b, int& R, int& C) {
  const int st = b / 1024, sb = b % 1024, swz = sb ^ (((sb >> 9) & 1) << 5);
  R = (st >> 1) * 16 + swz / 64;
  C = (st & 1) * 32 + (swz % 64) / 2;
}
DI void gemm_main(const u16* __restrict__ A, int lda, const u16* __restrict__ Bt, int ldb, int K, int row0, int col0,
                  char* lds, Acc8& acc, bool half_only = false) {
  const int tid = get_tid(), lane = tid & 63, wid = tid >> 6, wr = wid >> 2, wc = wid & 3, fr = lane & 15, fq = lane >> 4;
  constexpr int HTB = 128 * 64 * 2;
#define SA8(b, hh) (lds + ((b) * 2 + (hh)) * HTB)
#define SB8(b, hh) (lds + (4 + (b) * 2 + (hh)) * HTB)
  unsigned vo[2];
#pragma unroll
  for (int i = 0; i < 2; ++i) { int r_, c_; stage_rc8(tid * 16 + i * 8192, r_, c_); vo[i] = (unsigned)(r_ * lda + c_) * 2u; }
#define STAGE8(P, BASE, LD, br, kt)                                                                                         \
  do {                                                                                                                      \
    const char* _ub = (const char*)((BASE) + (size_t)(br) * (LD) + (size_t)(kt) * 64);                   \
    _Pragma("unroll") for (int _i = 0; _i < 2; ++_i)                                                                        \
      __builtin_amdgcn_global_load_lds((const unsigned*)(_ub + vo[_i]), LDSP((P) + tid * 16 + _i * 8192), 16, 0, 0);        \
  } while (0)
  const int obs = (fr * 64 + fq * 16) ^ ((((fr * 64 + fq * 16) >> 9) & 1) << 5);
  const int abase = wr * 8192 + obs, bbase = wc * 4096 + obs;
#define LDA8(dst, b, hh)                                                                                                    \
  _Pragma("unroll") for (int m = 0; m < 4; ++m) _Pragma("unroll") for (int k = 0; k < 2; ++k)                               \
    dst[m][k] = *(const bf16x8*)(SA8(b, hh) + abase + (2 * m + k) * 1024)
#define LDB8(dst, b, hh)                                                                                                    \
  _Pragma("unroll") for (int n = 0; n < 2; ++n) _Pragma("unroll") for (int k = 0; k < 2; ++k)                               \
    dst[n][k] = *(const bf16x8*)(SB8(b, hh) + bbase + (2 * n + k) * 1024)
#define MMA8(ai, bj, At_, Bt_)                                                                                              \
  do {                                                                                                                      \
    __builtin_amdgcn_s_setprio(1);                                                                                          \
    _Pragma("unroll") for (int m = 0; m < 4; ++m) _Pragma("unroll") for (int n = 0; n < 2; ++n)                             \
      _Pragma("unroll") for (int k = 0; k < 2; ++k)                                                                         \
        acc[ai][bj][m][n] = __builtin_amdgcn_mfma_f32_16x16x32_bf16(At_[m][k], Bt_[n][k], acc[ai][bj][m][n], 0, 0, 0);     \
    __builtin_amdgcn_s_setprio(0);                                                                                          \
  } while (0)
#define WAIT_V(n) asm volatile("s_waitcnt vmcnt(" #n ")" ::: "memory")
#define WAIT_L(n) asm volatile("s_waitcnt lgkmcnt(" #n ")" ::: "memory")
#define BAR8 __builtin_amdgcn_s_barrier()
#define SCHED8 __builtin_amdgcn_sched_barrier(0)
  const int brow = row0, bcol = col0;
  const bool fullm = row0 < 64 * 256 && !half_only;
  bf16x8 At[4][2], B0[2][2], B1[2][2];
  const int nt = K >> 6;
  __syncthreads();
  STAGE8(SB8(0, 0), Bt, ldb, bcol, 0); STAGE8(SA8(0, 0), A, lda, brow, 0);
  STAGE8(SB8(0, 1), Bt, ldb, bcol + 128, 0); STAGE8(SA8(0, 1), A, lda, brow + 128, 0);
  if (wr == 1) BAR8;
  WAIT_V(4); BAR8;
  STAGE8(SB8(1, 0), Bt, ldb, bcol, 1); STAGE8(SA8(1, 0), A, lda, brow, 1); STAGE8(SB8(1, 1), Bt, ldb, bcol + 128, 1);
  WAIT_V(6); BAR8;
#pragma unroll 1
  for (int t = 0; t < nt - 2; t += 2) {
    LDB8(B0, 0, 0); SCHED8; LDA8(At, 0, 0); STAGE8(SA8(1, 1), A, lda, brow + 128, t + 1);
    WAIT_L(8); BAR8; WAIT_L(0); MMA8(0, 0, At, B0); BAR8; SCHED8;
    LDB8(B1, 0, 1); STAGE8(SB8(0, 0), Bt, ldb, bcol, t + 2);
    BAR8; WAIT_L(0); MMA8(0, 1, At, B1); BAR8;
    if (fullm) { LDA8(At, 0, 1); } STAGE8(SA8(0, 0), A, lda, brow, t + 2);
    BAR8; WAIT_L(0); if (fullm) MMA8(1, 0, At, B0); BAR8; SCHED8;
    STAGE8(SB8(0, 1), Bt, ldb, bcol + 128, t + 2);
    WAIT_V(6); BAR8; if (fullm) MMA8(1, 1, At, B1); BAR8;
    LDB8(B0, 1, 0); SCHED8; LDA8(At, 1, 0); STAGE8(SA8(0, 1), A, lda, brow + 128, t + 2);
    WAIT_L(8); BAR8; WAIT_L(0); MMA8(0, 0, At, B0); BAR8; SCHED8;
    LDB8(B1, 1, 1); STAGE8(SB8(1, 0), Bt, ldb, bcol, t + 3);
    BAR8; WAIT_L(0); MMA8(0, 1, At, B1); BAR8;
    if (fullm) { LDA8(At, 1, 1); } STAGE8(SA8(1, 0), A, lda, brow, t + 3);
    BAR8; WAIT_L(0); if (fullm) MMA8(1, 0, At, B0); BAR8; SCHED8;
    STAGE8(SB8(1, 1), Bt, ldb, bcol + 128, t + 3);
    WAIT_V(6); BAR8; if (fullm) MMA8(1, 1, At, B1); BAR8;
  }
  {
    LDB8(B0, 0, 0); LDA8(At, 0, 0); STAGE8(SA8(1, 1), A, lda, brow + 128, nt - 1);
    BAR8; WAIT_L(0); MMA8(0, 0, At, B0); BAR8;
    LDB8(B1, 0, 1); BAR8; WAIT_L(0); MMA8(0, 1, At, B1); BAR8;
    if (fullm) { LDA8(At, 0, 1); } WAIT_V(4); BAR8; WAIT_L(0); if (fullm) MMA8(1, 0, At, B0); if (fullm) MMA8(1, 1, At, B1); BAR8;
  }
  {
    LDB8(B0, 1, 0); LDA8(At, 1, 0); WAIT_V(2); BAR8; WAIT_L(0); MMA8(0, 0, At, B0); BAR8;
    LDB8(B1, 1, 1); WAIT_V(0); BAR8; WAIT_L(0); MMA8(0, 1, At, B1); BAR8;
    if (fullm) { LDA8(At, 1, 1); } BAR8; WAIT_L(0); if (fullm) MMA8(1, 0, At, B0); if (fullm) MMA8(1, 1, At, B1); BAR8;
  }
  if (wr == 0) BAR8;
}

DI void zero_acc(Acc8& acc) {
#pragma unroll
  for (int a = 0; a < 2; ++a)
#pragma unroll
    for (int b = 0; b < 2; ++b)
#pragma unroll
      for (int m = 0; m < 4; ++m)
#pragma unroll
        for (int n = 0; n < 2; ++n)
#pragma unroll
          for (int j = 0; j < 4; ++j) acc[a][b][m][n][j] = 0.f;
}

DI void dump_ai(char* lds, const Acc8& acc, int ai, int wr, int wc, int fr, int fq) {
  char* base = lds + ((wr * 64 + fq * 4) * EPI_LD + wc * 32 + fr) * 4;
#pragma unroll
  for (int bj = 0; bj < 2; ++bj)
#pragma unroll
    for (int m = 0; m < 4; ++m)
#pragma unroll
      for (int n = 0; n < 2; ++n)
#pragma unroll
        for (int j = 0; j < 4; ++j)
          *(float*)(base + ((m * 16 + j) * EPI_LD + bj * 128 + n * 16) * 4) = ai ? acc[1][bj][m][n][j] : acc[0][bj][m][n][j];
}
DI void read8(const char* wl, int row, int col, float (&v)[8]) {
  const f32x4 a = *(const f32x4*)(wl + (row * EPI_LD + col) * 4);
  const f32x4 b = *(const f32x4*)(wl + (row * EPI_LD + col) * 4 + 16);
  v[0] = a[0]; v[1] = a[1]; v[2] = a[2]; v[3] = a[3]; v[4] = b[0]; v[5] = b[1]; v[6] = b[2]; v[7] = b[3];
}
DI u32x4 pack8v(const float (&v)[8]) { return pack8(v[0], v[1], v[2], v[3], v[4], v[5], v[6], v[7]); }
template <int CTRL>
DI float dpp_f(float v) { return __int_as_float(__builtin_amdgcn_mov_dpp(__float_as_int(v), CTRL, 0xf, 0xf, true)); }
DI float sum16(float v) {
  v += dpp_f<0xB1>(v);
  v += dpp_f<0x4E>(v);
  v += dpp_f<0x141>(v);
  v += dpp_f<0x140>(v);
  return v;
}
template <class B>
DI void epi_run(char* lds, const Acc8& acc, int nhalf, B body) {
  const int tid = threadIdx.x, lane = tid & 63, wid = tid >> 6, wr = wid >> 2, wc = wid & 3, fr = lane & 15, fq = lane >> 4;
  __syncthreads();
  dump_ai(lds, acc, 0, wr, wc, fr, fq);
  __syncthreads();
  body(0);
  if (nhalf > 1) {
    __syncthreads();
    dump_ai(lds, acc, 1, wr, wc, fr, fq);
    __syncthreads();
    body(128);
  }
}
DI void reload_ai(const char* lds, Acc8& acc, int ai, int wr, int wc, int fr, int fq) {
  const char* base = lds + ((wr * 64 + fq * 4) * EPI_LD + wc * 32 + fr) * 4;
#pragma unroll
  for (int bj = 0; bj < 2; ++bj)
#pragma unroll
    for (int m = 0; m < 4; ++m)
#pragma unroll
      for (int n = 0; n < 2; ++n)
#pragma unroll
        for (int j = 0; j < 4; ++j) {
          const float x = *(const float*)(base + ((m * 16 + j) * EPI_LD + bj * 128 + n * 16) * 4);
          if (ai) acc[1][bj][m][n][j] = x; else acc[0][bj][m][n][j] = x;
        }
}
template <class B>
DI void acc_transform(char* lds, Acc8& acc, int nhalf, B body) {
  const int tid = threadIdx.x, lane = tid & 63, wid = tid >> 6, wr = wid >> 2, wc = wid & 3, fr = lane & 15, fq = lane >> 4;
  __syncthreads();
  dump_ai(lds, acc, 0, wr, wc, fr, fq);
  __syncthreads();
  body(0);
  __syncthreads();
  reload_ai(lds, acc, 0, wr, wc, fr, fq);
  if (nhalf > 1) {
    __syncthreads();
    dump_ai(lds, acc, 1, wr, wc, fr, fq);
    __syncthreads();
    body(128);
    __syncthreads();
    reload_ai(lds, acc, 1, wr, wc, fr, fq);
  }
}
DI u16* krow_ptr(char* ws, int row) {
  if (row < NP) return (u16*)(ws + OFF_KP) + (size_t)row * 160;
  return (u16*)(ws + OFF_KS) + (size_t)(((row - NP) >> 4) * KSROWS + PAST + ((row - NP) & 15)) * 160;
}

DI bool tile_of(int r, int b, int nn  , int& mi, int& ni) {
  const int nsup = nn >> 2;
  const int xcd = (b >> 5) & 7, slot = b & 31;
  if (r < nsup) { mi = xcd * 8 + (slot & 7); ni = r * 4 + (slot >> 3); return true; }
  int idx = (r - nsup) * 256 + b;
  const int nrem = nn & 3;
  if (idx < 64 * nrem) { mi = idx & 63; ni = 4 * nsup + (idx >> 6); return true; }
  idx -= 64 * nrem;
  if (idx < nn) { mi = 64; ni = idx; return true; }
  return false;
}

#define BW_CTR 0
#define BW_CNT(x) (64 + 64 * (x))
#define BW_XSUB(x) (1024 + 64 * (x))
#define BW_XGEN(x) (2048 + 64 * (x))
#define BW_TOP 3072
#define BW_TOPGEN 3136
#define BW_MCNT 3200
DI unsigned bar_ld(unsigned* p) { return __hip_atomic_load(p, __ATOMIC_RELAXED, __HIP_MEMORY_SCOPE_AGENT); }
DI unsigned bar_add(unsigned* p, unsigned v) { return __hip_atomic_fetch_add(p, v, __ATOMIC_RELAXED, __HIP_MEMORY_SCOPE_AGENT); }
DI void bar_st(unsigned* p, unsigned v) { __hip_atomic_store(p, v, __ATOMIC_RELAXED, __HIP_MEMORY_SCOPE_AGENT); }
DI void grid_barrier_xcd(unsigned* bar, unsigned k, unsigned xcc, unsigned my_cnt, unsigned nx) {
  asm volatile("s_waitcnt vmcnt(0)" ::: "memory");
  __syncthreads();
  if (threadIdx.x == 0) {
    const unsigned old = bar_add(bar + BW_XSUB(xcc), 1u);
    if (old == k * my_cnt - 1u) {
      __builtin_amdgcn_fence(__ATOMIC_RELEASE, "agent");
      asm volatile("s_waitcnt vmcnt(0)" ::: "memory");
      const unsigned t = bar_add(bar + BW_TOP, 1u);
      if (t == k * nx - 1u) bar_st(bar + BW_TOPGEN, k);
      else while (bar_ld(bar + BW_TOPGEN) < k) __builtin_amdgcn_s_sleep(1);
      bar_st(bar + BW_XGEN(xcc), k);
    } else {
      while (bar_ld(bar + BW_XGEN(xcc)) < k) __builtin_amdgcn_s_sleep(1);
    }
    __builtin_amdgcn_fence(__ATOMIC_ACQUIRE, "agent");
    asm volatile("s_waitcnt vmcnt(0)" ::: "memory");
  }
  __syncthreads();
}
DI void grid_barrier(unsigned* ctr, unsigned target) {
  asm volatile("s_waitcnt vmcnt(0)" ::: "memory");
  __syncthreads();
  if (threadIdx.x == 0) {
    __builtin_amdgcn_fence(__ATOMIC_RELEASE, "agent");
    asm volatile("s_waitcnt vmcnt(0)" ::: "memory");
    __hip_atomic_fetch_add(ctr, 1u, __ATOMIC_RELAXED, __HIP_MEMORY_SCOPE_AGENT);
    while (__hip_atomic_load(ctr, __ATOMIC_RELAXED, __HIP_MEMORY_SCOPE_AGENT) < target) __builtin_amdgcn_s_sleep(2);
    __builtin_amdgcn_fence(__ATOMIC_ACQUIRE, "agent");
    asm volatile("s_waitcnt vmcnt(0)" ::: "memory");
  }
  __syncthreads();
}

DI void epi1(const Params& p, Acc8& acc, int row0, int col0, char* lds) {
  const int tid = get_tid(), lane = tid & 63, wave = tid >> 6, wr = wave >> 1, wc = wave & 1;
  const int l31 = lane & 31, h = lane >> 5;
  const int rowbase = row0 + wr * 32;
  const int nhalf = (row0 + 128 >= NR) ? 1 : 2;
  const int e = (col0 >> 7) + wc;
  char* wl = lds + (wr * 32 * EPI_LD + wc * 128) * 4;
  char* ws = p.ws;
  const float* rstdx = (const float*)(ws + OFF_RSTDX);
  {
    const int gwr = wave >> 2, fq = lane >> 4;
#pragma unroll
    for (int ai = 0; ai < 2; ++ai)
#pragma unroll
      for (int m = 0; m < 4; ++m) {
        float rs[4];
#pragma unroll
        for (int j = 0; j < 4; ++j) rs[j] = rstdx[row0 + ai * 128 + gwr * 64 + m * 16 + fq * 4 + j];
#pragma unroll
        for (int bj = 0; bj < 2; ++bj)
#pragma unroll
          for (int n = 0; n < 2; ++n)
#pragma unroll
            for (int j = 0; j < 4; ++j) acc[ai][bj][m][n][j] *= rs[j];
      }
  }
  if (e < 2 || (e >= 4 && e < 8) || e >= 24) {
    u16* dst; int ld, cb;
    if (e < 2) { dst = (u16*)(ws + OFF_QLAT); ld = 256; cb = e * 128; }
    else if (e < 8) { dst = (u16*)(ws + OFF_SG); ld = 512; cb = (e - 4) * 128; }
    else { dst = (u16*)(ws + (e < 32 ? OFF_SA : OFF_SB)); ld = 1024; cb = ((e - 24) & 7) * 128; }
    float* ssq = (float*)(ws + OFF_SSQQ);
    epi_run(lds, acc, nhalf, [&](int mb) {
#pragma unroll 2
      for (int it = 0; it < 8; ++it) {
        const int lr = it * 4 + (lane >> 4), ch = lane & 15;
        const int row = rowbase + mb + lr;
        float v[8];
        read8(wl, lr, ch * 8, v);
        if (e < 2) {
          float s = 0.f;
#pragma unroll
          for (int j = 0; j < 8; ++j) s += v[j] * v[j];
          s = sum16(s);
          if (ch == 0) atomicAdd(&ssq[row], s);
        } else if (e < 8) {
#pragma unroll
          for (int j = 0; j < 8; ++j) v[j] = silu_f(v[j]);
        } else {
#pragma unroll
          for (int j = 0; j < 8; ++j) v[j] = sigm_f(v[j]);
        }
        *(u32x4*)(dst + (size_t)row * ld + cb + ch * 8) = pack8v(v);
      }
    });
  } else if (e == 2) {
    const float* kvg = p.in[9];
    epi_run(lds, acc, nhalf, [&](int mb) {
#pragma unroll 2
      for (int it = 0; it < 8; ++it) {
        const int lr = it * 4 + (lane >> 4), ch = lane & 15;
        const int row = rowbase + mb + lr;
        float v[8];
        read8(wl, lr, ch * 8, v);
        float s = 0.f;
#pragma unroll
        for (int j = 0; j < 8; ++j) s += v[j] * v[j];
        s = sum16(s);
        const float rk = rsqrtf(s * (1.f / 128.f) + EPS);
        const f32x4 g0 = *(const f32x4*)(kvg + ch * 8), g1 = *(const f32x4*)(kvg + ch * 8 + 4);
#pragma unroll
        for (int j = 0; j < 4; ++j) { v[j] *= rk * g0[j]; v[4 + j] *= rk * g1[j]; }
        if (row < NR) {
          float* o = (row < NP ? p.out + O_CKVP + (size_t)row * 128 : p.out + O_CKVS + (size_t)(row - NP) * 128) + ch * 8;
          f32x4 o0 = {v[0], v[1], v[2], v[3]}, o1 = {v[4], v[5], v[6], v[7]};
          *(f32x4*)o = o0;
          *(f32x4*)(o + 4) = o1;
          *(u32x4*)(krow_ptr(ws, row) + ch * 8) = pack8v(v);
        }
      }
    });
  } else if (e == 3) {
    epi_run(lds, acc, nhalf, [&](int mb) {
      const int lr = lane >> 1, hf = lane & 1;
      const int row = rowbase + mb + lr;
      float x1[8], x2[8], o1[8], o2[8];
      read8(wl, lr, hf * 8, x1);
      read8(wl, lr, 16 + hf * 8, x2);
      const float* tb = (const float*)(ws + OFF_ROPE) + row_pos(row) * 32 + hf * 8;
      float cc[8], sn[8];
      { const f32x4 t0 = *(const f32x4*)tb, t1 = *(const f32x4*)(tb + 4), t2 = *(const f32x4*)(tb + 16), t3 = *(const f32x4*)(tb + 20);
#pragma unroll
        for (int j = 0; j < 4; ++j) { cc[j] = t0[j]; cc[4 + j] = t1[j]; sn[j] = t2[j]; sn[4 + j] = t3[j]; } }
#pragma unroll
      for (int j = 0; j < 8; ++j) {
        const float a = x1[j], b = x2[j];
        o1[j] = a * cc[j] - b * sn[j];
        o2[j] = b * cc[j] + a * sn[j];
      }
      if (row < NR) {
        float* o = (row < NP ? p.out + O_KPEP + (size_t)row * 32 : p.out + O_KPES + (size_t)(row - NP) * 32) + hf * 8;
        f32x4 a0 = {o1[0], o1[1], o1[2], o1[3]}, a1 = {o1[4], o1[5], o1[6], o1[7]};
        f32x4 b0 = {o2[0], o2[1], o2[2], o2[3]}, b1 = {o2[4], o2[5], o2[6], o2[7]};
        *(f32x4*)o = a0; *(f32x4*)(o + 4) = a1;
        *(f32x4*)(o + 16) = b0; *(f32x4*)(o + 20) = b1;
        u16* k = krow_ptr(ws, row) + 128 + hf * 8;
        *(u32x4*)k = pack8v(o1);
        *(u32x4*)(k + 16) = pack8v(o2);
      }
    });
  } else {
    const int g = e - 8;
    u16* U = (u16*)(ws + OFF_U);
    u16* V = (u16*)(ws + OFF_V);
    u16* CB = (u16*)(ws + OFF_CB);
    const float* cw = p.in[13];
    const bool fused = row0 < NP;
    float* side = (float*)(lds + SIDE_OFF);
    const char* strip = lds + (wc * 128) * 4;
    epi_run(lds, acc, nhalf, [&](int mb) {
#pragma unroll 1
      for (int it = 0; it < 2; ++it) {
        const int lr = it * 16 + (lane >> 2), sub = lane & 3;
        const int hr = wr * 32 + lr;
        const int row = rowbase + mb + lr;
        float vb[8], vc[8], vx[8], vg[8], u[8], vv[8];
        read8(wl, lr, sub * 8, vb);
        read8(wl, lr, 32 + sub * 8, vc);
        read8(wl, lr, 64 + sub * 8, vx);
        read8(wl, lr, 96 + sub * 8, vg);
#pragma unroll
        for (int j = 0; j < 8; ++j) {
          u[j] = vc[j] * vx[j];
          vv[j] = vb[j] * silu_f(vg[j]);
        }
        const size_t o = (size_t)row * 512 + g * 32 + sub * 8;
        const int r256 = row & 255;
        if (!fused || r256 < 2 || r256 >= 254) {
          *(u32x4*)(U + o) = pack8v(u);
          *(u32x4*)(V + o) = pack8v(vv);
        }
        if (fused) {
          if (mb == 0 && hr >= 126) {
#pragma unroll
            for (int j = 0; j < 8; ++j) side[(hr - 126) * 64 + wc * 32 + sub * 8 + j] = u[j];
          }
          if (hr >= 2 || mb == 128) {
            float u1[8], u2[8];
            if (hr >= 1) {
              float c1[8], x1[8];
              read8(strip, hr - 1, 32 + sub * 8, c1);
              read8(strip, hr - 1, 64 + sub * 8, x1);
#pragma unroll
              for (int j = 0; j < 8; ++j) u1[j] = c1[j] * x1[j];
            } else {
#pragma unroll
              for (int j = 0; j < 8; ++j) u1[j] = side[64 + wc * 32 + sub * 8 + j];
            }
            if (hr >= 2) {
              float c2[8], x2[8];
              read8(strip, hr - 2, 32 + sub * 8, c2);
              read8(strip, hr - 2, 64 + sub * 8, x2);
#pragma unroll
              for (int j = 0; j < 8; ++j) u2[j] = c2[j] * x2[j];
            } else {
#pragma unroll
              for (int j = 0; j < 8; ++j) u2[j] = side[hr * 64 + wc * 32 + sub * 8 + j];
            }
            const float* w = cw + g * 32 + sub * 8;
            float r[8];
#pragma unroll
            for (int j = 0; j < 8; ++j) r[j] = vv[j] * (w[j] * u2[j] + w[512 + j] * u1[j] + w[1024 + j] * u[j]);
            *(u32x4*)(CB + o) = pack8v(r);
          }
        }
        float* cs = nullptr;
        if (row < NP) {
          const int t = row & (SEQ - 1);
          if (t >= SEQ - 2) cs = p.out + O_CONVP + (size_t)((row >> 13) * 2 + (t - (SEQ - 2))) * 512;
        } else if (row < NR) {
          const int t = (row - NP) & 15;
          if (t >= DSEQ - 2) cs = p.out + O_CONVS + (size_t)(((row - NP) >> 4) * 2 + (t - (DSEQ - 2))) * 512;
        }
        if (cs) {
          f32x4 a0 = {u[0], u[1], u[2], u[3]}, a1 = {u[4], u[5], u[6], u[7]};
          *(f32x4*)(cs + g * 32 + sub * 8) = a0;
          *(f32x4*)(cs + g * 32 + sub * 8 + 4) = a1;
        }
      }
    });
  }
}

DI void phase1(const Params& p, char* lds, int vb) {
  const u16* xb = (const u16*)(p.ws + OFF_XB);
  const u16* win = (const u16*)(p.ws + OFF_WIN);
  for (int r = 0;; ++r) {
    int mi, ni;
    if (!tile_of(r, vb, 20, mi, ni)) break;
    Acc8 acc;
    zero_acc(acc);
    gemm_main(xb, 1024, win, 1024, 1024, mi * 256, ni * 256, lds, acc);
    epi1(p, acc, mi * 256, ni * 256, lds);
  }
  if (gridDim.x > 40) {
    if (vb >= 20) prep_late(p, (vb - 20) * 512 + get_tid(), ((int)gridDim.x - 20) * 512);
  } else {
    prep_late(p, blockIdx.x * 512 + get_tid(), gridDim.x * 512);
  }
}

DI void phase2(const Params& p, char* lds, int vb) {
  const int tid = get_tid(), lane = tid & 63, wave = tid >> 6, wr = wave >> 1, wc = wave & 1;
  const int l31 = lane & 31, h = lane >> 5;
  char* ws = p.ws;
  const u16* ql = (const u16*)(ws + OFF_QLAT);
  const u16* wq = (const u16*)(ws + OFF_WQ);
  const float* ssq = (const float*)(ws + OFF_SSQQ);
  u16* qp = (u16*)(ws + OFF_QP);
  char* wl = lds + (wr * 32 * EPI_LD + wc * 128) * 4;
  for (int r = 0; r < 2; ++r) {
    int row0, col0;
    bool halfu = false;
    if (r == 0) {
      int mi, ni;
      if (!tile_of(0, vb, 5, mi, ni)) break;
      row0 = mi * 256; col0 = ni * 256;
    } else if (vb < 128) {
      row0 = vb * 128; col0 = 4 * 256; halfu = true;
    } else if (vb < 133) {
      row0 = 64 * 256; col0 = (vb - 128) * 256;
    } else break;
    Acc8 acc;
    zero_acc(acc);
    gemm_main(ql, 256, wq, 256, 256, row0, col0, lds, acc, halfu);
    const int rowbase = row0 + wr * 32;
    const int colbase = col0 + wc * 128;
    epi_run(lds, acc, (halfu || row0 + 128 >= NR) ? 1 : 2, [&](int mb) {
#pragma unroll 2
      for (int it = 0; it < 8; ++it) {
        const int lr = it * 4 + (lane >> 4), ch = lane & 15;
        const int row = rowbase + mb + lr;
        const float r = rsqrtf(ssq[row] * (1.f / 256.f) + EPS);
        float v[8], o[8];
        read8(wl, lr, ch * 8, v);
#pragma unroll
        for (int j = 0; j < 8; ++j) { v[j] *= r; o[j] = dpp_f<0x4E>(v[j]); }
        const int gt = (colbase >> 5) + (ch >> 2);
        if (gt % 5 == 4) {
          const int sub = ch & 3;
          const float* tb = (const float*)(ws + OFF_ROPE) + row_pos(row) * 32 + (sub & 1) * 8;
          const f32x4 t0 = *(const f32x4*)tb, t1 = *(const f32x4*)(tb + 4), t2 = *(const f32x4*)(tb + 16), t3 = *(const f32x4*)(tb + 20);
          const float sg = sub < 2 ? -1.f : 1.f;
#pragma unroll
          for (int j = 0; j < 4; ++j) {
            v[j] = v[j] * t0[j] + sg * o[j] * t2[j];
            v[4 + j] = v[4 + j] * t1[j] + sg * o[4 + j] * t3[j];
          }
        }
        *(u32x4*)(qp + (size_t)row * 1280 + colbase + ch * 8) = pack8v(v);
      }
    });
  }
  {
    const u16* U = (const u16*)(ws + OFF_U);
    const u16* V = (const u16*)(ws + OFF_V);
    u16* cb = (u16*)(ws + OFF_CB);
    const float* cw = p.in[13];
    const float* st = p.in[4];
    const bool part = gridDim.x > 160;
    const int gtid = part ? (vb - 133) * 512 + tid : (int)blockIdx.x * 512 + tid, nth = part ? ((int)gridDim.x - 133) * 512 : (int)gridDim.x * 512;
    if (!part || vb >= 133)
    for (int idx = gtid; idx < 256 * 64; idx += nth) {
      const int ri = idx >> 6, c8 = (idx & 63) * 8;
      const int row = ri < 128 ? (ri >> 1) * 256 + (ri & 1) : NP + (ri - 128);
      const u32x4 vv = *(const u32x4*)(V + (size_t)row * 512 + c8);
      const u32x4 u0 = *(const u32x4*)(U + (size_t)row * 512 + c8);
      float u1[8], u2[8];
      int t; const float* s0 = nullptr;
      if (row < NP) t = row & (SEQ - 1);
      else { t = (row - NP) & 15; s0 = st + (size_t)((row - NP) >> 4) * 1024 + c8; }
      if (t >= 1) {
        const u32x4 q = *(const u32x4*)(U + (size_t)(row - 1) * 512 + c8);
#pragma unroll
        for (int j = 0; j < 4; ++j) { u1[2 * j] = bf2f((u16)(q[j] & 0xffff)); u1[2 * j + 1] = bf2f((u16)(q[j] >> 16)); }
      } else {
#pragma unroll
        for (int j = 0; j < 8; ++j) u1[j] = s0 ? s0[512 + j] : 0.f;
      }
      if (t >= 2) {
        const u32x4 q = *(const u32x4*)(U + (size_t)(row - 2) * 512 + c8);
#pragma unroll
        for (int j = 0; j < 4; ++j) { u2[2 * j] = bf2f((u16)(q[j] & 0xffff)); u2[2 * j + 1] = bf2f((u16)(q[j] >> 16)); }
      } else {
#pragma unroll
        for (int j = 0; j < 8; ++j) u2[j] = s0 ? s0[(t == 0 ? 0 : 512) + j] : 0.f;
      }
      float r[8];
#pragma unroll
      for (int j = 0; j < 8; ++j) {
        const float uu = bf2f((u16)((j & 1) ? (u0[j >> 1] >> 16) : (u0[j >> 1] & 0xffff)));
        const float vj = bf2f((u16)((j & 1) ? (vv[j >> 1] >> 16) : (vv[j >> 1] & 0xffff)));
        r[j] = vj * (cw[c8 + j] * u2[j] + cw[512 + c8 + j] * u1[j] + cw[1024 + c8 + j] * uu);
      }
      *(u32x4*)(cb + (size_t)row * 512 + c8) = pack8(r[0], r[1], r[2], r[3], r[4], r[5], r[6], r[7]);
    }
  }
}

DI void attn_item(const Params& p, char* lds, const u16* __restrict__ Kbase, int nkt, int last_valid, size_t qrow0, int qmask, int nq) {
  const int tid = get_tid(), lane = tid & 63, head = tid >> 6;
  const int l31 = lane & 31, h = lane >> 5;
  char* ws = p.ws;
  const size_t R = qrow0 + (size_t)(l31 & qmask);
  const u16* qsrc = (const u16*)(ws + OFF_QP) + R * 1280 + head * 160 + 8 * h;
  bf16x8 qf[10];
#pragma unroll
  for (int s = 0; s < 10; ++s) qf[s] = *(const bf16x8*)(qsrc + 16 * s);
  f32x16 O[4];
#pragma unroll
  for (int dt = 0; dt < 4; ++dt)
#pragma unroll
    for (int i = 0; i < 16; ++i) O[dt][i] = 0.f;
  float m = -1e30f, l = 0.f;
  const int r0 = tid >> 4, c0 = (tid & 15) ^ (((r0 & 3) << 2) | ((r0 >> 2) & 3));
  const int rr = (tid >> 2) & 63, rc = (tid & 3) ^ ((rr >> 2) & 3);
  const u16* g0 = Kbase + (size_t)r0 * 160 + c0 * 8;
  const u16* gr = Kbase + (size_t)rr * 160 + 128 + rc * 8;
  char* sdst = lds + tid * 16;
#define LDSP(x) ((__attribute__((address_space(3))) unsigned*)(x))
  __syncthreads();
  __builtin_amdgcn_global_load_lds((const unsigned*)g0, LDSP(sdst), 16, 0, 0);
  __builtin_amdgcn_global_load_lds((const unsigned*)(g0 + 32 * 160), LDSP(sdst + 8192), 16, 0, 0);
  if (tid < 256) __builtin_amdgcn_global_load_lds((const unsigned*)gr, LDSP(sdst + 16384), 16, 0, 0);
  asm volatile("s_waitcnt vmcnt(0)" ::: "memory");
  __syncthreads();
  const int kkey = ((l31 & 3) << 2) | ((l31 >> 2) & 3);
  const int krow = 256 * l31;
  const int rkey = (l31 >> 2) & 3;
  const int rrow = 16384 + 64 * l31;
  const int qq = (lane & 15) >> 2, pp = lane & 3, blk = (lane >> 4) & 1, cl = 2 * blk + (pp >> 1);
  unsigned va[2][4];
#pragma unroll
  for (int t = 0; t < 2; ++t)
#pragma unroll
    for (int dt = 0; dt < 4; ++dt)
      va[t][dt] = 256 * (8 * t + 4 * h + qq) + 64 * (dt ^ qq) + 16 * (cl ^ ((2 * t + h) & 3)) + 8 * (pp & 1);
  const unsigned ldsbase = (unsigned)(size_t)lds;
  for (int jt = 0; jt < nkt; ++jt) {
    const int cur = jt & 1;
    const bool more = jt + 1 < nkt;
    if (more) {
      const size_t go = (size_t)(jt + 1) * 64 * 160;
      char* wb = sdst + (cur ^ 1) * 20480;
      __builtin_amdgcn_global_load_lds((const unsigned*)(g0 + go), LDSP(wb), 16, 0, 0);
      __builtin_amdgcn_global_load_lds((const unsigned*)(g0 + go + 32 * 160), LDSP(wb + 8192), 16, 0, 0);
      if (tid < 256) __builtin_amdgcn_global_load_lds((const unsigned*)(gr + go), LDSP(wb + 16384), 16, 0, 0);
    }
    const char* kb = lds + cur * 20480;
    f32x16 S[2];
#pragma unroll
    for (int i = 0; i < 16; ++i) { S[0][i] = 0.f; S[1][i] = 0.f; }
    {
      bf16x8 ka[2][2];
#pragma unroll
      for (int kt2 = 0; kt2 < 2; ++kt2) ka[0][kt2] = *(const bf16x8*)(kb + krow + kt2 * 8192 + ((h ^ kkey) << 4));
#pragma unroll
      for (int s = 0; s < 10; ++s) {
        if (s + 1 < 8) {
          const int co = ((2 * (s + 1) + h) ^ kkey) << 4;
#pragma unroll
          for (int kt2 = 0; kt2 < 2; ++kt2) ka[(s + 1) & 1][kt2] = *(const bf16x8*)(kb + krow + kt2 * 8192 + co);
        } else if (s + 1 < 10) {
          const int co = ((2 * (s + 1 - 8) + h) ^ rkey) << 4;
#pragma unroll
          for (int kt2 = 0; kt2 < 2; ++kt2) ka[(s + 1) & 1][kt2] = *(const bf16x8*)(kb + rrow + kt2 * 2048 + co);
        }
#pragma unroll
        for (int kt2 = 0; kt2 < 2; ++kt2) S[kt2] = MFMA(ka[s & 1][kt2], qf[s], S[kt2]);
      }
    }
    if (!more && last_valid < 64) {
      const int thr = last_valid - 4 * h;
#pragma unroll
      for (int kt2 = 0; kt2 < 2; ++kt2)
#pragma unroll
        for (int i = 0; i < 16; ++i)
          if (kt2 * 32 + (i & 3) + 8 * (i >> 2) >= thr) S[kt2][i] = -1e30f;
    }
    float mx = S[0][0];
#pragma unroll
    for (int i = 1; i < 16; ++i) mx = fmaxf(mx, S[0][i]);
#pragma unroll
    for (int i = 0; i < 16; ++i) mx = fmaxf(mx, S[1][i]);
    {
      const auto sw = __builtin_amdgcn_permlane32_swap(__float_as_uint(mx), __float_as_uint(mx), false, false);
      mx = fmaxf(__uint_as_float(sw[0]), __uint_as_float(sw[1]));
    }
    const bool grow = __builtin_amdgcn_ballot_w64(mx > m + 2.f) != 0;
    const float mn = grow ? fmaxf(m, mx) : m;
    const float alpha = __builtin_amdgcn_exp2f(m - mn);
    m = mn;
    float ps = 0.f;
#pragma unroll
    for (int kt2 = 0; kt2 < 2; ++kt2)
#pragma unroll
      for (int i = 0; i < 16; ++i) {
        const float e = __builtin_amdgcn_exp2f(S[kt2][i] - mn);
        S[kt2][i] = e;
        ps += e;
      }
    l = l * alpha + ps;
    if (__builtin_amdgcn_ballot_w64(alpha != 1.f) != 0) {
#pragma unroll
      for (int dt = 0; dt < 4; ++dt)
#pragma unroll
        for (int i = 0; i < 16; ++i) O[dt][i] *= alpha;
    }
    unsigned vc[2][4];
#pragma unroll
    for (int t = 0; t < 2; ++t)
#pragma unroll
      for (int dt = 0; dt < 4; ++dt) vc[t][dt] = va[t][dt] + ldsbase + cur * 20480;
#pragma unroll
    for (int kt2 = 0; kt2 < 2; ++kt2)
#pragma unroll
      for (int s2 = 0; s2 < 2; ++s2) {
        const bf16x8 pf = pack_step(S[kt2], s2);
        s16x4 v00, v01, v02, v03, v10, v11, v12, v13;
        asm volatile(
            "ds_read_b64_tr_b16 %0, %8 offset:%16\n\t"
            "ds_read_b64_tr_b16 %1, %9 offset:%16\n\t"
            "ds_read_b64_tr_b16 %2, %10 offset:%16\n\t"
            "ds_read_b64_tr_b16 %3, %11 offset:%16\n\t"
            "ds_read_b64_tr_b16 %4, %12 offset:%16\n\t"
            "ds_read_b64_tr_b16 %5, %13 offset:%16\n\t"
            "ds_read_b64_tr_b16 %6, %14 offset:%16\n\t"
            "ds_read_b64_tr_b16 %7, %15 offset:%16\n\t"
            "s_waitcnt lgkmcnt(0)"
            : "=&v"(v00), "=&v"(v01), "=&v"(v02), "=&v"(v03), "=&v"(v10), "=&v"(v11), "=&v"(v12), "=&v"(v13)
            : "v"(vc[0][0]), "v"(vc[0][1]), "v"(vc[0][2]), "v"(vc[0][3]),
              "v"(vc[1][0]), "v"(vc[1][1]), "v"(vc[1][2]), "v"(vc[1][3]), "n"((kt2 * 32 + 16 * s2) * 256)
            : "memory");
        O[0] = MFMA(__builtin_shufflevector(v00, v10, 0, 1, 2, 3, 4, 5, 6, 7), pf, O[0]);
        O[1] = MFMA(__builtin_shufflevector(v01, v11, 0, 1, 2, 3, 4, 5, 6, 7), pf, O[1]);
        O[2] = MFMA(__builtin_shufflevector(v02, v12, 0, 1, 2, 3, 4, 5, 6, 7), pf, O[2]);
        O[3] = MFMA(__builtin_shufflevector(v03, v13, 0, 1, 2, 3, 4, 5, 6, 7), pf, O[3]);
      }
    asm volatile("s_waitcnt vmcnt(0)" ::: "memory");
    __syncthreads();
  }
  l += __shfl_xor(l, 32);
  const float inv = 1.f / l;
#pragma unroll
  for (int dt = 0; dt < 4; ++dt)
#pragma unroll
    for (int i = 0; i < 16; ++i) O[dt][i] *= inv;
  f32x16 o2[2];
#pragma unroll
  for (int i = 0; i < 16; ++i) { o2[0][i] = 0.f; o2[1][i] = 0.f; }
  const bf16x8* wf = (const bf16x8*)(ws + OFF_WUV) + (size_t)head * 16 * 64 + lane;
#pragma unroll
  for (int dt = 0; dt < 4; ++dt)
#pragma unroll
    for (int s2 = 0; s2 < 2; ++s2) {
      const bf16x8 b = pack_step(O[dt], s2);
#pragma unroll
      for (int mt = 0; mt < 2; ++mt) {
        const bf16x8 a = wf[((mt * 4 + dt) * 2 + s2) * 64];
        o2[mt] = MFMA(a, b, o2[mt]);
      }
    }
  if (l31 < nq) {
    const u16* sg = (const u16*)(ws + OFF_SG) + R * 512 + head * 64 + 4 * h;
    u16* og = (u16*)(ws + OFF_U) + R * 512 + head * 64 + 4 * h;
#pragma unroll
    for (int mt = 0; mt < 2; ++mt)
#pragma unroll
      for (int g4 = 0; g4 < 4; ++g4) {
        const u32x2 gv = *(const u32x2*)(sg + mt * 32 + 8 * g4);
        const float a0 = o2[mt][4 * g4 + 0] * bf2f((u16)(gv[0] & 0xffff));
        const float a1 = o2[mt][4 * g4 + 1] * bf2f((u16)(gv[0] >> 16));
        const float a2 = o2[mt][4 * g4 + 2] * bf2f((u16)(gv[1] & 0xffff));
        const float a3 = o2[mt][4 * g4 + 3] * bf2f((u16)(gv[1] >> 16));
        u32x2 ov = {pack2(a0, a1), pack2(a2, a3)};
        *(u32x2*)(og + mt * 32 + 8 * g4) = ov;
      }
  }
}

DI void phase3(const Params& p, char* lds) {
  const u16* kp = (const u16*)(p.ws + OFF_KP);
  const u16* ks = (const u16*)(p.ws + OFF_KS);
  const int nb = gridDim.x;
#pragma unroll 1
  for (int j = 0;; ++j) {
    int id;
    if (nb == 256) { if (j >= 4) break; id = p.sched[blockIdx.x][j]; if (id < 0) break; }
    else { id = blockIdx.x + j * nb; if (id >= 520) break; }
    const u16* kb; int nkt, lastv, qmask, nq; size_t q0;
    if (id < 512) {
      const int b = id >> 8, hc = id & 255;
      kb = kp + (size_t)b * SEQ * 160; nkt = (hc >> 1) + 1; lastv = 64; q0 = (size_t)b * SEQ + hc * 32; qmask = 31; nq = 32;
    } else {
      const int b = id - 512;
      kb = ks + (size_t)b * KSROWS * 160; nkt = 17; lastv = 16; q0 = (size_t)NP + b * 16; qmask = 15; nq = 16;
    }
    attn_item(p, lds, kb, nkt, lastv, q0, qmask, nq);
  }
}

DI void unpack8(const u32x4 q, float (&f)[8]) {
#pragma unroll
  for (int j = 0; j < 4; ++j) { f[2 * j] = bf2f((u16)(q[j] & 0xffff)); f[2 * j + 1] = bf2f((u16)(q[j] >> 16)); }
}
DI void phase4a(const Params& p, char* lds, int vb) {
  const int tid = get_tid(), lane = tid & 63, wave = tid >> 6, wr = wave >> 1, wc = wave & 1;
  const int l31 = lane & 31, h = lane >> 5;
  char* ws = p.ws;
  const u16* og = (const u16*)(ws + OFF_U);
  const u16* cb = (const u16*)(ws + OFF_CB);
  const u16* woa = (const u16*)(ws + OFF_WOA);
  const u16* wob = (const u16*)(ws + OFF_WOB);
  const u16* sa = (const u16*)(ws + OFF_SA);
  const u16* sb = (const u16*)(ws + OFF_SB);
  u16* mg = (u16*)(ws + OFF_XB);
  char* wl = lds + (wr * 32 * EPI_LD + wc * 128) * 4;
  for (int r = 0;; ++r) {
    int mi, ni;
    if (!tile_of(r, vb, 4, mi, ni)) break;
    const int row0 = mi * 256, col0 = ni * 256;
    const int rowbase = row0 + wr * 32, colbase = col0 + wc * 128;
    const int nhalf = (row0 + 128 >= NR) ? 1 : 2;
    Acc8 acc;
    zero_acc(acc);
#pragma unroll 1
    for (int pass = 0; pass < 2; ++pass) {
      gemm_main(pass ? cb : og, 512, pass ? wob : woa, 512, 512, row0, col0, lds, acc);
      if (pass == 0) {
        acc_transform(lds, acc, nhalf, [&](int mb) {
#pragma unroll 2
          for (int it = 0; it < 8; ++it) {
            const int lr = it * 4 + (lane >> 4), ch = lane & 15;
            const size_t o = (size_t)(rowbase + mb + lr) * 1024 + colbase + ch * 8;
            float v[8], ga[8], gb[8];
            read8(wl, lr, ch * 8, v);
            unpack8(*(const u32x4*)(sa + o), ga);
            unpack8(*(const u32x4*)(sb + o), gb);
#pragma unroll
            for (int j = 0; j < 8; ++j) v[j] *= ga[j] * __builtin_amdgcn_rcpf(fmaxf(gb[j], 1e-30f));
            const f32x4 w0 = {v[0], v[1], v[2], v[3]}, w1 = {v[4], v[5], v[6], v[7]};
            *(f32x4*)(wl + (lr * EPI_LD + ch * 8) * 4) = w0;
            *(f32x4*)(wl + (lr * EPI_LD + ch * 8) * 4 + 16) = w1;
          }
        });
      } else {
        epi_run(lds, acc, nhalf, [&](int mb) {
#pragma unroll 2
          for (int it = 0; it < 8; ++it) {
            const int lr = it * 4 + (lane >> 4), ch = lane & 15;
            const size_t o = (size_t)(rowbase + mb + lr) * 1024 + colbase + ch * 8;
            float v[8], gb[8];
            read8(wl, lr, ch * 8, v);
            unpack8(*(const u32x4*)(sb + o), gb);
#pragma unroll
            for (int j = 0; j < 8; ++j) v[j] *= fmaxf(gb[j], 1e-30f);
            *(u32x4*)(mg + o) = pack8v(v);
          }
        });
      }
    }
  }
}

DI void phase4b(const Params& p, char* lds, int vb) {
  const int tid = get_tid(), lane = tid & 63, wave = tid >> 6, wr = wave >> 1, wc = wave & 1;
  const int l31 = lane & 31, h = lane >> 5;
  char* ws = p.ws;
  const u16* mg = (const u16*)(ws + OFF_XB);
  const u16* wo = (const u16*)(ws + OFF_WOUT);
  u16* z = (u16*)(ws + OFF_QP);
  float* ssq = (float*)(ws + OFF_SSQZ);
  char* wl = lds + (wr * 32 * EPI_LD + wc * 128) * 4;
  for (int r = 0; r < 1; ++r) {
    int mi, ni;
    if (!tile_of(r, vb, 4, mi, ni)) break;
    const int row0 = mi * 256, col0 = ni * 256;
    const int rowbase = row0 + wr * 32, colbase = col0 + wc * 128;
    Acc8 acc;
    zero_acc(acc);
    gemm_main(mg, 1024, wo, 1024, 1024, row0, col0, lds, acc);
    epi_run(lds, acc, 2, [&](int mb) {
#pragma unroll 2
      for (int it = 0; it < 8; ++it) {
        const int lr = it * 4 + (lane >> 4), ch = lane & 15;
        const int row = rowbase + mb + lr;
        float v[8];
        read8(wl, lr, ch * 8, v);
        float s = 0.f;
#pragma unroll
        for (int j = 0; j < 8; ++j) s += v[j] * v[j];
        s = sum16(s);
        if (ch == 0) atomicAdd(&ssq[row], s);
      }
    });
    asm volatile("s_waitcnt vmcnt(0)" ::: "memory");
    __syncthreads();
    if (threadIdx.x == 0) {
      unsigned* c = (unsigned*)(ws + OFF_BAR) + BW_MCNT + mi;
      bar_add(c, 1u);
      while (bar_ld(c) < 4u) __builtin_amdgcn_s_sleep(1);
    }
    __syncthreads();
    const float* pg = p.in[16];
    epi_run(lds, acc, 2, [&](int mb) {
#pragma unroll 2
      for (int it = 0; it < 8; ++it) {
        const int lr = it * 4 + (lane >> 4), ch = lane & 15;
        const int row = rowbase + mb + lr;
        const int col = colbase + ch * 8;
        float v[8];
        read8(wl, lr, ch * 8, v);
        const float r = rsqrtf(__hip_atomic_load(&ssq[row], __ATOMIC_RELAXED, __HIP_MEMORY_SCOPE_AGENT) * (1.f / 1024.f) + EPS);
        const float* xs = p.in[0] + (size_t)row * 1024 + col;
        const f32x4 x0 = *(const f32x4*)xs, x1 = *(const f32x4*)(xs + 4);
        const f32x4 g0 = *(const f32x4*)(pg + col), g1 = *(const f32x4*)(pg + col + 4);
        f32x4 y0, y1;
#pragma unroll
        for (int j = 0; j < 4; ++j) { y0[j] = x0[j] + v[j] * r * g0[j]; y1[j] = x1[j] + v[4 + j] * r * g1[j]; }
        float* yd = p.out + O_YP + (size_t)row * 1024 + col;
        *(f32x4*)yd = y0;
        *(f32x4*)(yd + 4) = y1;
      }
    });
  }
  if (vb < 16) {
    const int ni = vb >> 2, ks = vb & 3;
    Acc8 acc;
    zero_acc(acc);
    gemm_main(mg + ks * 256, 1024, wo + ks * 256, 1024, 256, 64 * 256, ni * 256, lds, acc);
    float* zs = (float*)(ws + OFF_ZS);
    const int gwr = wave >> 2, gwc = wave & 3, fr = lane & 15, fq = lane >> 4;
#pragma unroll
    for (int bj = 0; bj < 2; ++bj)
#pragma unroll
      for (int m = 0; m < 4; ++m)
#pragma unroll
        for (int n = 0; n < 2; ++n)
#pragma unroll
          for (int j = 0; j < 4; ++j)
            atomicAdd(&zs[(size_t)(gwr * 64 + m * 16 + fq * 4 + j) * 1024 + ni * 256 + bj * 128 + gwc * 32 + n * 16 + fr], acc[0][bj][m][n][j]);
  }
}

DI void phase5(const Params& p) {
  const int tid = get_tid(), lane = tid & 63, wave = tid >> 6;
  const int gtid = blockIdx.x * 512 + tid, nth = gridDim.x * 512;
  const u16* z = (const u16*)(p.ws + OFF_QP);
  const float* ssq = (const float*)(p.ws + OFF_SSQZ);
  const float* pg = p.in[16];
  const float* zs = (const float*)(p.ws + OFF_ZS);
  for (int srow = blockIdx.x * 8 + wave; srow < NS; srow += gridDim.x * 8) {
    f32x4 v[4];
    float ss = 0.f;
#pragma unroll
    for (int i = 0; i < 4; ++i) {
      v[i] = *(const f32x4*)(zs + (size_t)srow * 1024 + (i * 64 + lane) * 4);
      ss += v[i][0] * v[i][0] + v[i][1] * v[i][1] + v[i][2] * v[i][2] + v[i][3] * v[i][3];
    }
    ss = wave_sum(ss);
    const float r = rsqrtf(ss * (1.f / 1024.f) + EPS);
#pragma unroll
    for (int i = 0; i < 4; ++i) {
      const int c4 = (i * 64 + lane) * 4;
      const f32x4 x = *(const f32x4*)(p.in[1] + (size_t)srow * 1024 + c4);
      const f32x4 g = *(const f32x4*)(pg + c4);
      f32x4 y;
#pragma unroll
      for (int j = 0; j < 4; ++j) y[j] = x[j] + v[i][j] * r * g[j];
      *(f32x4*)(p.out + O_YS + (size_t)srow * 1024 + c4) = y;
    }
  }
}

template <int PH>
DI void run_phase(const Params& p, char* lds, int vb) {
  if constexpr (PH == 0) phase0(p);
  else if constexpr (PH == 1) phase1(p, lds, vb);
  else if constexpr (PH == 2) phase2(p, lds, vb);
  else if constexpr (PH == 3) phase3(p, lds);
  else if constexpr (PH == 4) phase4a(p, lds, vb);
  else if constexpr (PH == 5) phase4b(p, lds, vb);
  else phase5(p);
}

template <int PH>
__global__ void __launch_bounds__(512) fwd_kernel(Params p) {
  extern __shared__ __attribute__((aligned(16))) char lds[];
  if constexpr (PH >= 0) {
    run_phase<PH>(p, lds, (int)blockIdx.x);
  } else {
    unsigned* bar = (unsigned*)(p.ws + OFF_BAR);
    const unsigned nb = gridDim.x;
    if (p.ph_hi < 0) cg::this_grid().sync();
    const unsigned xcc = (unsigned)__builtin_amdgcn_s_getreg((3 << 11) | 20) & 7u;
    if (threadIdx.x == 0) *(unsigned*)lds = bar_add(bar + BW_CNT(xcc), 1u);
    __syncthreads();
    const unsigned slot = (unsigned)__builtin_amdgcn_readfirstlane((int)*(volatile unsigned*)lds);
    __syncthreads();
    run_phase<0>(p, lds, 0);
    if (threadIdx.x == 0) {
      unsigned tot;
      do {
        tot = 0;
        for (unsigned x = 0; x < 8; ++x) tot += bar_ld(bar + BW_CNT(x));
        if (tot < nb) __builtin_amdgcn_s_sleep(1);
      } while (tot < nb);
    }
    __syncthreads();
    unsigned vbu = slot, my_cnt = 0, nx = 0;
    for (unsigned x = 0; x < 8; ++x) {
      const unsigned c = bar_ld(bar + BW_CNT(x));
      if (x < xcc) vbu += c;
      if (x == xcc) my_cnt = c;
      nx += c ? 1u : 0u;
    }
    const int vb = __builtin_amdgcn_readfirstlane((int)vbu);
    my_cnt = (unsigned)__builtin_amdgcn_readfirstlane((int)my_cnt);
    nx = (unsigned)__builtin_amdgcn_readfirstlane((int)nx);
    grid_barrier_xcd(bar, 1, xcc, my_cnt, nx);
    run_phase<1>(p, lds, vb); grid_barrier_xcd(bar, 2, xcc, my_cnt, nx);
    run_phase<2>(p, lds, vb); grid_barrier_xcd(bar, 3, xcc, my_cnt, nx);
    run_phase<3>(p, lds, vb); grid_barrier_xcd(bar, 4, xcc, my_cnt, nx);
    run_phase<4>(p, lds, vb); grid_barrier_xcd(bar, 5, xcc, my_cnt, nx);
    run_phase<5>(p, lds, vb); grid_barrier_xcd(bar, 6, xcc, my_cnt, nx);
    run_phase<6>(p, lds, vb);
  }
}

template <int PH>
static void launch_phase(const Params& p, int grid, hipStream_t stream) {
  static bool attr_set = false;
  if (!attr_set) {
    if (hipFuncSetAttribute((const void*)fwd_kernel<PH>, hipFuncAttributeMaxDynamicSharedMemorySize, LDS_BYTES) != hipSuccess)
      fprintf(stderr, "kernel_launch: hipFuncSetAttribute failed (phase %d)\n", PH);
    attr_set = true;
  }
  hipLaunchKernelGGL(fwd_kernel<PH>, dim3(grid), dim3(512), LDS_BYTES, stream, p);
}

extern "C" void kernel_launch(void* const* d_in, const int* in_sizes, int n_in, void* d_out, int out_size, void* d_ws,
                              size_t ws_size, hipStream_t stream) {
  static int grid = 0;
  if (grid == 0) {
    if (n_in != 17 || ws_size < WS_END) {
      fprintf(stderr, "kernel_launch: unexpected n_in %d or ws_size %zu (< %zu)\n", n_in, ws_size, (size_t)WS_END);
      grid = -1;
      return;
    }
    int dev = 0, cus = 0;
    (void)hipGetDevice(&dev);
    (void)hipDeviceGetAttribute(&cus, hipDeviceAttributeMultiprocessorCount, dev);
#if ONE_LAUNCH
    int per_cu = 0;
    if (hipFuncSetAttribute((const void*)fwd_kernel<-1>, hipFuncAttributeMaxDynamicSharedMemorySize, LDS_BYTES) != hipSuccess)
      fprintf(stderr, "kernel_launch: hipFuncSetAttribute failed\n");
    (void)hipOccupancyMaxActiveBlocksPerMultiprocessor(&per_cu, (const void*)fwd_kernel<-1>, 512, LDS_BYTES);
    if (per_cu < 1) fprintf(stderr, "kernel_launch: occupancy query says %d blocks/CU\n", per_cu);
    (void)hipGetLastError();
#endif
    grid = cus;
  }
  if (grid < 0) return;
  Params p{};
  {
    int load[256] = {0}, cnt[256] = {0};
    for (int b = 0; b < 256; ++b) for (int j = 0; j < 4; ++j) p.sched[b][j] = -1;
    auto place = [&](int id, int cost) {
      int best = -1;
      for (int b = 0; b < 256; ++b) if (cnt[b] < 4 && (best < 0 || load[b] < load[best])) best = b;
      p.sched[best][cnt[best]++] = (short)id;
      load[best] += cost + 3;
    };
    for (int cost = 128; cost >= 1; --cost) {
      if (cost == 17) for (int s = 0; s < 8; ++s) place(512 + s, 17);
      const int c = cost - 1;
      for (int b = 0; b < 2; ++b) for (int hf = 0; hf < 2; ++hf) place(b * 256 + c * 2 + hf, cost);
    }
  }
  for (int i = 0; i < 17; ++i) p.in[i] = (const float*)d_in[i];
  p.out = (float*)d_out;
  p.ws = (char*)d_ws;
  p.ph_lo = 0;
  p.ph_hi = 7;
  (void)hipMemsetAsync((char*)d_ws + OFF_BAR, 0, BAR_BYTES, stream);
#if ONE_LAUNCH
  void* args[] = {&p};
  hipError_t e = hipLaunchCooperativeKernel((const void*)fwd_kernel<-1>, dim3(grid), dim3(512), args, LDS_BYTES, stream);
  if (e != hipSuccess) fprintf(stderr, "cooperative launch failed: %s (grid %d)\n", hipGetErrorString(e), grid);
#else
  launch_phase<0>(p, grid, stream);
  launch_phase<1>(p, grid, stream);
#if PROBE_REPEAT == 1
  launch_phase<0>(p, grid, stream);
  launch_phase<1>(p, grid, stream);
#endif
  launch_phase<2>(p, grid, stream);
#if PROBE_REPEAT == 2
  launch_phase<2>(p, grid, stream);
#endif
  launch_phase<3>(p, grid, stream);
#if PROBE_REPEAT == 3
  launch_phase<3>(p, grid, stream);
#endif
  launch_phase<4>(p, grid, stream);
#if PROBE_REPEAT == 4
  launch_phase<4>(p, grid, stream);
#endif
  launch_phase<5>(p, grid, stream);
  launch_phase<6>(p, grid, stream);
#endif
}
```

```cpp
#include <hip/hip_runtime.h>
#include <hip/hip_cooperative_groups.h>
#include <cstdio>
namespace cg = cooperative_groups;

#ifndef PHASE_MASK
#define PHASE_MASK 127
#endif
#ifndef ONE_LAUNCH
#define ONE_LAUNCH 1
#endif
#ifndef PROBE_REPEAT
#define PROBE_REPEAT 0
#endif

#define DI __device__ __forceinline__
typedef unsigned short u16;
typedef __attribute__((ext_vector_type(8))) short bf16x8;
typedef __attribute__((ext_vector_type(4))) short s16x4;
typedef __attribute__((ext_vector_type(16))) float f32x16;
typedef __attribute__((ext_vector_type(4))) float f32x4;
typedef __attribute__((ext_vector_type(4))) unsigned u32x4;
typedef __attribute__((ext_vector_type(2))) unsigned u32x2;
typedef __attribute__((ext_vector_type(2))) __bf16 bf2_t;
typedef __attribute__((ext_vector_type(2))) float f2_t;
#define MFMA(a, b, c) __builtin_amdgcn_mfma_f32_32x32x16_bf16((a), (b), (c), 0, 0, 0)

constexpr int NP = 16384, NS = 128, NR = NP + NS, NRP = 16640;
constexpr int SEQ = 8192, PAST = 1024, DSEQ = 16, KSROWS = 1088;
constexpr int INC = 5024;
constexpr float EPS = 1e-6f;
constexpr float QSCALE = 0.10206207261596575f * 1.4426950408889634f;
constexpr int EPI_LD = 260;
constexpr int SIDE_OFF = 128 * EPI_LD * 4;
constexpr int LDS_BYTES = 128 * EPI_LD * 4 + 512;

constexpr size_t SZ_ROWS1024 = (size_t)NRP * 1024 * 2;
constexpr size_t SZ_ROWS512 = (size_t)NRP * 512 * 2;
constexpr size_t OFF_XB = 0;
constexpr size_t OFF_QP = OFF_XB + SZ_ROWS1024;
constexpr size_t OFF_WIN = OFF_QP + (size_t)NRP * 1280 * 2;
constexpr size_t OFF_WQ = OFF_WIN + (size_t)5120 * 1024 * 2;
constexpr size_t OFF_WOA = OFF_WQ + (size_t)1280 * 256 * 2;
constexpr size_t OFF_WOB = OFF_WOA + (size_t)1024 * 512 * 2;
constexpr size_t OFF_WOUT = OFF_WOB + (size_t)1024 * 512 * 2;
constexpr size_t OFF_WUV = OFF_WOUT + (size_t)1024 * 1024 * 2;
constexpr size_t OFF_QLAT = OFF_WUV + 131072;
constexpr size_t OFF_KP = OFF_QLAT + (size_t)NRP * 256 * 2;
constexpr size_t OFF_KS = OFF_KP + (size_t)2 * SEQ * 160 * 2;
constexpr size_t OFF_SG = OFF_KS + (size_t)8 * KSROWS * 160 * 2;
constexpr size_t OFF_U = OFF_SG + SZ_ROWS512;
constexpr size_t OFF_V = OFF_U + SZ_ROWS512;
constexpr size_t OFF_CB = OFF_V + SZ_ROWS512;
constexpr size_t OFF_SA = OFF_CB + SZ_ROWS512;
constexpr size_t OFF_SB = OFF_SA + SZ_ROWS1024;
constexpr size_t OFF_RSTDX = OFF_SB + SZ_ROWS1024;
constexpr size_t OFF_SSQQ = OFF_RSTDX + (size_t)NRP * 4;
constexpr size_t OFF_SSQZ = OFF_SSQQ + (size_t)NRP * 4;
constexpr size_t OFF_ROPE = OFF_SSQZ + (size_t)NRP * 4;
constexpr size_t OFF_ZS = OFF_ROPE + (size_t)SEQ * 32 * 4;
constexpr size_t OFF_BAR = OFF_ZS + (size_t)NS * 1024 * 4;
constexpr size_t BAR_BYTES = 16384;
constexpr size_t WS_END = OFF_BAR + BAR_BYTES;

constexpr size_t O_YP = 0;
constexpr size_t O_YS = O_YP + (size_t)NP * 1024;
constexpr size_t O_CKVP = O_YS + (size_t)NS * 1024;
constexpr size_t O_KPEP = O_CKVP + (size_t)NP * 128;
constexpr size_t O_CONVP = O_KPEP + (size_t)NP * 32;
constexpr size_t O_CKVS = O_CONVP + (size_t)2 * 2 * 512;
constexpr size_t O_KPES = O_CKVS + (size_t)NS * 128;
constexpr size_t O_CONVS = O_KPES + (size_t)NS * 32;

struct Params {
  const float* in[17];
  float* out;
  char* ws;
  int ph_lo, ph_hi;
  short sched[256][4];
};

DI int get_tid() { int t = threadIdx.x; asm volatile("" : "+v"(t)); return t; }
DI float bf2f(u16 v) { return __uint_as_float(((unsigned)v) << 16); }
DI unsigned pack2(float a, float b) {
  f2_t v = {a, b};
  bf2_t r = __builtin_convertvector(v, bf2_t);
  return __builtin_bit_cast(unsigned, r);
}
DI u16 f2bf(float a) { return (u16)(pack2(a, 0.f) & 0xffffu); }
DI int crow(int i, int h) { return (i & 3) + 8 * (i >> 2) + 4 * h; }
DI float wave_sum(float v) {
  v += __shfl_xor(v, 1); v += __shfl_xor(v, 2); v += __shfl_xor(v, 4);
  v += __shfl_xor(v, 8); v += __shfl_xor(v, 16); v += __shfl_xor(v, 32);
  return v;
}
DI float half_sum(float v) {
  v += __shfl_xor(v, 1); v += __shfl_xor(v, 2); v += __shfl_xor(v, 4);
  v += __shfl_xor(v, 8); v += __shfl_xor(v, 16);
  return v;
}
DI float sigm_f(float v) { return __builtin_amdgcn_rcpf(1.f + __builtin_amdgcn_exp2f(-1.4426950408889634f * v)); }
DI float silu_f(float v) { return v * sigm_f(v); }
DI int row_pos(int row) { return row < NP ? (row & (SEQ - 1)) : PAST + ((row - NP) & (DSEQ - 1)); }
DI void rope_cs(int pos, int i, float& c, float& s) {
  const int a = i & 3, b = i >> 2;
  double base = a == 0 ? 1.0 : (a == 1 ? 0.5623413251903491 : (a == 2 ? 0.31622776601683794 : 0.1778279410038923));
  double sc = b == 0 ? 1.0 : (b == 1 ? 0.1 : (b == 2 ? 0.01 : 0.001));
  const float invf = (float)(base * sc);
  double rev = (double)pos * (double)invf * 0.15915494309189535;
  rev = rev - floor(rev);
  const float r = (float)rev;
  c = __builtin_amdgcn_cosf(r);
  s = __builtin_amdgcn_sinf(r);
}
DI u32x4 pack8(float a0, float a1, float a2, float a3, float a4, float a5, float a6, float a7) {
  u32x4 o = {pack2(a0, a1), pack2(a2, a3), pack2(a4, a5), pack2(a6, a7)};
  return o;
}
DI bf16x8 pack_step(const f32x16& x, int s) {
  u32x4 o;
  if (s == 0) o = pack8(x[0], x[1], x[2], x[3], x[4], x[5], x[6], x[7]);
  else o = pack8(x[8], x[9], x[10], x[11], x[12], x[13], x[14], x[15]);
  return __builtin_bit_cast(bf16x8, o);
}

DI int colmap(int n2) {
  if (n2 < 256) return n2;
  if (n2 < 512) { int j = n2 - 256; return j < 160 ? 256 + j : -1; }
  if (n2 < 1024) return 416 + (n2 - 512);
  if (n2 < 3072) { int g = (n2 - 1024) >> 7, w = (n2 - 1024) & 127; return 928 + (w >> 5) * 512 + g * 32 + (w & 31); }
  if (n2 < 4096) return 2976 + (n2 - 3072);
  return 4000 + (n2 - 4096);
}

DI void transpose_w(const float* __restrict__ src, int Ks, int Ns, u16* __restrict__ dst, int gtid, int nth) {
  const int total = Ns * (Ks >> 3);
  for (int idx = gtid; idx < total; idx += nth) {
    const int n = idx % Ns, k8 = idx / Ns;
    float v[8];
#pragma unroll
    for (int j = 0; j < 8; ++j) v[j] = src[(size_t)(k8 * 8 + j) * Ns + n];
    *(u32x4*)(dst + (size_t)n * Ks + k8 * 8) = pack8(v[0], v[1], v[2], v[3], v[4], v[5], v[6], v[7]);
  }
}

DI void prep_late(const Params& p, int gtid, int nth) {
  char* ws = p.ws;
  {
    const float* wuq = p.in[8];
    const float* wuk = p.in[10];
    const float* qg = p.in[7];
    u16* dst = (u16*)(ws + OFF_WQ);
    for (int idx = gtid; idx < 1280 * 256; idx += nth) {
      const int n2 = idx >> 8, k = idx & 255;
      const int hd = n2 / 160, j = n2 % 160;
      float val;
      if (j < 128) {
        const float* a = wuq + (size_t)k * 768 + hd * 96;
        const float* b = wuk + (size_t)(j * 8 + hd) * 64;
        float s = 0.f;
        for (int d = 0; d < 64; ++d) s += a[d] * b[d];
        val = s;
      } else {
        val = wuq[(size_t)k * 768 + hd * 96 + 64 + (j - 128)];
      }
      dst[idx] = f2bf(val * qg[k] * QSCALE);
    }
  }
  transpose_w(p.in[12], 512, 1024, (u16*)(ws + OFF_WOA), gtid, nth);
  transpose_w(p.in[14], 512, 1024, (u16*)(ws + OFF_WOB), gtid, nth);
  transpose_w(p.in[15], 1024, 1024, (u16*)(ws + OFF_WOUT), gtid, nth);
  {
    const float* wuv = p.in[11];
    u16* dst = (u16*)(ws + OFF_WUV);
    for (int idx = gtid; idx < 65536; idx += nth) {
      const int j = idx & 7, ln = (idx >> 3) & 63, s = (idx >> 9) & 1, dt = (idx >> 10) & 3, mt = (idx >> 12) & 1, hd = idx >> 13;
      const int col = 32 * mt + (ln & 31);
      const int c = 32 * dt + 16 * s + 8 * (j >> 2) + 4 * (ln >> 5) + (j & 3);
      dst[idx] = f2bf(wuv[(size_t)(c * 8 + hd) * 64 + col]);
    }
  }
  {
    const float* ckv = p.in[2];
    const float* ckr = p.in[3];
    u16* dst = (u16*)(ws + OFF_KS);
    for (int idx = gtid; idx < 8 * KSROWS * 20; idx += nth) {
      const int ch = idx % 20, r = (idx / 20) % KSROWS, b = idx / (20 * KSROWS);
      u32x4 o = {0u, 0u, 0u, 0u};
      if (r < PAST) {
        const float* src = ch < 16 ? ckv + ((size_t)(b * PAST + r) * 128 + ch * 8) : ckr + ((size_t)(b * PAST + r) * 32 + (ch - 16) * 8);
        const f32x4 v0 = *(const f32x4*)src, v1 = *(const f32x4*)(src + 4);
        o = pack8(v0[0], v0[1], v0[2], v0[3], v1[0], v1[1], v1[2], v1[3]);
      } else if (r < PAST + DSEQ) continue;
      *(u32x4*)(dst + (size_t)(b * KSROWS + r) * 160 + ch * 8) = o;
    }
  }
}

DI void phase0(const Params& p) {
  const int tid = get_tid(), lane = tid & 63, wave = tid >> 6;
  const int nblk = gridDim.x, gtid = blockIdx.x * 512 + tid, nth = nblk * 512;
  char* ws = p.ws;
  {
    u16* xb = (u16*)(ws + OFF_XB);
    float* rstdx = (float*)(ws + OFF_RSTDX);
    for (int row = blockIdx.x * 8 + wave; row < NRP; row += nblk * 8) {
      u16* dst = xb + (size_t)row * 1024;
      if (row < NR) {
        const float* src = row < NP ? p.in[0] + (size_t)row * 1024 : p.in[1] + (size_t)(row - NP) * 1024;
        float ss = 0.f;
#pragma unroll
        for (int i = 0; i < 4; ++i) {
          const f32x4 v = *(const f32x4*)(src + (i * 64 + lane) * 4);
          ss += v[0] * v[0] + v[1] * v[1] + v[2] * v[2] + v[3] * v[3];
          u32x2 o = {pack2(v[0], v[1]), pack2(v[2], v[3])};
          *(u32x2*)(dst + (i * 64 + lane) * 4) = o;
        }
        ss = wave_sum(ss);
        if (lane == 0) rstdx[row] = rsqrtf(ss * (1.f / 1024.f) + EPS);
      } else {
#pragma unroll
        for (int i = 0; i < 4; ++i) { u32x2 o = {0u, 0u}; *(u32x2*)(dst + (i * 64 + lane) * 4) = o; }
        if (lane == 0) rstdx[row] = 0.f;
      }
    }
  }
  {
    const float* w = p.in[6];
    const float* g = p.in[5];
    u16* dst = (u16*)(ws + OFF_WIN);
    for (int idx = gtid; idx < 5120 * 128; idx += nth) {
      const int n2 = idx % 5120, k8 = idx / 5120;
      const int n = colmap(n2);
      u32x4 o = {0u, 0u, 0u, 0u};
      if (n >= 0) {
        float v[8];
#pragma unroll
        for (int j = 0; j < 8; ++j) v[j] = w[(size_t)(k8 * 8 + j) * INC + n] * g[k8 * 8 + j];
        o = pack8(v[0], v[1], v[2], v[3], v[4], v[5], v[6], v[7]);
      }
      *(u32x4*)(dst + (size_t)n2 * 1024 + k8 * 8) = o;
    }
  }
  {
    float* tab = (float*)(ws + OFF_ROPE);
    for (int idx = gtid; idx < SEQ * 16; idx += nth) {
      float c, sn;
      rope_cs(idx >> 4, idx & 15, c, sn);
      tab[(idx >> 4) * 32 + (idx & 15)] = c;
      tab[(idx >> 4) * 32 + 16 + (idx & 15)] = sn;
    }
  }
  {
    float* a = (float*)(ws + OFF_SSQQ);
    float* b = (float*)(ws + OFF_SSQZ);
    for (int idx = gtid; idx < NRP; idx += nth) { a[idx] = 0.f; b[idx] = 0.f; }
    f32x4* zs = (f32x4*)(ws + OFF_ZS);
    const f32x4 z4 = {0.f, 0.f, 0.f, 0.f};
    for (int idx = gtid; idx < NS * 256; idx += nth) zs[idx] = z4;
  }
}

typedef f32x4 Acc8[2][2][4][2];
#define LDSP(x) ((__attribute__((address_space(3))) unsigned*)(x))
DI int lds_byte8(int r, int c) {
  const int st = (r >> 4) * 2 + (c >> 5), rr = r & 15, cc = c & 31, ob = rr * 64 + cc * 2;
  return st * 1024 + (ob ^ (((ob >> 9) & 1) << 5));
}
DI void stage_rc8(int b, int& R, int& C) {
  const int st = b / 1024, sb = b % 1024, swz = sb ^ (((sb >> 9) & 1) << 5);
  R = (st >> 1) * 16 + swz / 64;
  C = (st & 1) * 32 + (swz % 64) / 2;
}
DI void gemm_main(const u16* __restrict__ A, int lda, const u16* __restrict__ Bt, int ldb, int K, int row0, int col0,
                  char* lds, Acc8& acc, bool half_only = false) {
  const int tid = get_tid(), lane = tid & 63, wid = tid >> 6, wr = wid >> 2, wc = wid & 3, fr = lane & 15, fq = lane >> 4;
  constexpr int HTB = 128 * 64 * 2;
#define SA8(b, hh) (lds + ((b) * 2 + (hh)) * HTB)
#define SB8(b, hh) (lds + (4 + (b) * 2 + (hh)) * HTB)
  unsigned vo[2];
#pragma unroll
  for (int i = 0; i < 2; ++i) { int r_, c_; stage_rc8(tid * 16 + i * 8192, r_, c_); vo[i] = (unsigned)(r_ * lda + c_) * 2u; }
#define STAGE8(P, BASE, LD, br, kt)                                                                                         \
  do {                                                                                                                      \
    const char* _ub = (const char*)((BASE) + (size_t)(br) * (LD) + (size_t)(kt) * 64);                   \
    _Pragma("unroll") for (int _i = 0; _i < 2; ++_i)                                                                        \
      __builtin_amdgcn_global_load_lds((const unsigned*)(_ub + vo[_i]), LDSP((P) + tid * 16 + _i * 8192), 16, 0, 0);        \
  } while (0)
  const int obs = (fr * 64 + fq * 16) ^ ((((fr * 64 + fq * 16) >> 9) & 1) << 5);
  const int abase = wr * 8192 + obs, bbase = wc * 4096 + obs;
#define LDA8(dst, b, hh)                                                                                                    \
  _Pragma("unroll") for (int m = 0; m < 4; ++m) _Pragma("unroll") for (int k = 0; k < 2; ++k)                               \
    dst[m][k] = *(const bf16x8*)(SA8(b, hh) + abase + (2 * m + k) * 1024)
#define LDB8(dst, b, hh)                                                                                                    \
  _Pragma("unroll") for (int n = 0; n < 2; ++n) _Pragma("unroll") for (int k = 0; k < 2; ++k)                               \
    dst[n][k] = *(const bf16x8*)(SB8(b, hh) + bbase + (2 * n + k) * 1024)
#define MMA8(ai, bj, At_, Bt_)                                                                                              \
  do {                                                                                                                      \
    __builtin_amdgcn_s_setprio(1);                                                                                          \
    _Pragma("unroll") for (int m = 0; m < 4; ++m) _Pragma("unroll") for (int n = 0; n < 2; ++n)                             \
      _Pragma("unroll") for (int k = 0; k < 2; ++k)                                                                         \
        acc[ai][bj][m][n] = __builtin_amdgcn_mfma_f32_16x16x32_bf16(At_[m][k], Bt_[n][k], acc[ai][bj][m][n], 0, 0, 0);     \
    __builtin_amdgcn_s_setprio(0);                                                                                          \
  } while (0)
#define WAIT_V(n) asm volatile("s_waitcnt vmcnt(" #n ")" ::: "memory")
#define WAIT_L(n) asm volatile("s_waitcnt lgkmcnt(" #n ")" ::: "memory")
#define BAR8 __builtin_amdgcn_s_barrier()
#define SCHED8 __builtin_amdgcn_sched_barrier(0)
  const int brow = row0, bcol = col0;
  const bool fullm = row0 < 64 * 256 && !half_only;
  bf16x8 At[4][2], B0[2][2], B1[2][2];
  const int nt = K >> 6;
  __syncthreads();
  STAGE8(SB8(0, 0), Bt, ldb, bcol, 0); STAGE8(SA8(0, 0), A, lda, brow, 0);
  STAGE8(SB8(0, 1), Bt, ldb, bcol + 128, 0); STAGE8(SA8(0, 1), A, lda, brow + 128, 0);
  if (wr == 1) BAR8;
  WAIT_V(4); BAR8;
  STAGE8(SB8(1, 0), Bt, ldb, bcol, 1); STAGE8(SA8(1, 0), A, lda, brow, 1); STAGE8(SB8(1, 1), Bt, ldb, bcol + 128, 1);
  WAIT_V(6); BAR8;
#pragma unroll 1
  for (int t = 0; t < nt - 2; t += 2) {
    LDB8(B0, 0, 0); SCHED8; LDA8(At, 0, 0); STAGE8(SA8(1, 1), A, lda, brow + 128, t + 1);
    WAIT_L(8); BAR8; WAIT_L(0); MMA8(0, 0, At, B0); BAR8; SCHED8;
    LDB8(B1, 0, 1); STAGE8(SB8(0, 0), Bt, ldb, bcol, t + 2);
    BAR8; WAIT_L(0); MMA8(0, 1, At, B1); BAR8;
    LDA8(At, 0, 1); STAGE8(SA8(0, 0), A, lda, brow, t + 2);
    BAR8; WAIT_L(0); if (fullm) MMA8(1, 0, At, B0); BAR8; SCHED8;
    STAGE8(SB8(0, 1), Bt, ldb, bcol + 128, t + 2);
    WAIT_V(6); BAR8; if (fullm) MMA8(1, 1, At, B1); BAR8;
    LDB8(B0, 1, 0); SCHED8; LDA8(At, 1, 0); STAGE8(SA8(0, 1), A, lda, brow + 128, t + 2);
    WAIT_L(8); BAR8; WAIT_L(0); MMA8(0, 0, At, B0); BAR8; SCHED8;
    LDB8(B1, 1, 1); STAGE8(SB8(1, 0), Bt, ldb, bcol, t + 3);
    BAR8; WAIT_L(0); MMA8(0, 1, At, B1); BAR8;
    LDA8(At, 1, 1); STAGE8(SA8(1, 0), A, lda, brow, t + 3);
    BAR8; WAIT_L(0); if (fullm) MMA8(1, 0, At, B0); BAR8; SCHED8;
    STAGE8(SB8(1, 1), Bt, ldb, bcol + 128, t + 3);
    WAIT_V(6); BAR8; if (fullm) MMA8(1, 1, At, B1); BAR8;
  }
  {
    LDB8(B0, 0, 0); LDA8(At, 0, 0); STAGE8(SA8(1, 1), A, lda, brow + 128, nt - 1);
    BAR8; WAIT_L(0); MMA8(0, 0, At, B0); BAR8;
    LDB8(B1, 0, 1); BAR8; WAIT_L(0); MMA8(0, 1, At, B1); BAR8;
    LDA8(At, 0, 1); WAIT_V(4); BAR8; WAIT_L(0); if (fullm) MMA8(1, 0, At, B0); if (fullm) MMA8(1, 1, At, B1); BAR8;
  }
  {
    LDB8(B0, 1, 0); LDA8(At, 1, 0); WAIT_V(2); BAR8; WAIT_L(0); MMA8(0, 0, At, B0); BAR8;
    LDB8(B1, 1, 1); WAIT_V(0); BAR8; WAIT_L(0); MMA8(0, 1, At, B1); BAR8;
    LDA8(At, 1, 1); BAR8; WAIT_L(0); if (fullm) MMA8(1, 0, At, B0); if (fullm) MMA8(1, 1, At, B1); BAR8;
  }
  if (wr == 0) BAR8;
}

DI void zero_acc(Acc8& acc) {
#pragma unroll
  for (int a = 0; a < 2; ++a)
#pragma unroll
    for (int b = 0; b < 2; ++b)
#pragma unroll
      for (int m = 0; m < 4; ++m)
#pragma unroll
        for (int n = 0; n < 2; ++n)
#pragma unroll
          for (int j = 0; j < 4; ++j) acc[a][b][m][n][j] = 0.f;
}

DI void dump_ai(char* lds, const Acc8& acc, int ai, int wr, int wc, int fr, int fq) {
  char* base = lds + ((wr * 64 + fq * 4) * EPI_LD + wc * 32 + fr) * 4;
#pragma unroll
  for (int bj = 0; bj < 2; ++bj)
#pragma unroll
    for (int m = 0; m < 4; ++m)
#pragma unroll
      for (int n = 0; n < 2; ++n)
#pragma unroll
        for (int j = 0; j < 4; ++j)
          *(float*)(base + ((m * 16 + j) * EPI_LD + bj * 128 + n * 16) * 4) = ai ? acc[1][bj][m][n][j] : acc[0][bj][m][n][j];
}
DI void read8(const char* wl, int row, int col, float (&v)[8]) {
  const f32x4 a = *(const f32x4*)(wl + (row * EPI_LD + col) * 4);
  const f32x4 b = *(const f32x4*)(wl + (row * EPI_LD + col) * 4 + 16);
  v[0] = a[0]; v[1] = a[1]; v[2] = a[2]; v[3] = a[3]; v[4] = b[0]; v[5] = b[1]; v[6] = b[2]; v[7] = b[3];
}
DI u32x4 pack8v(const float (&v)[8]) { return pack8(v[0], v[1], v[2], v[3], v[4], v[5], v[6], v[7]); }
template <int CTRL>
DI float dpp_f(float v) { return __int_as_float(__builtin_amdgcn_mov_dpp(__float_as_int(v), CTRL, 0xf, 0xf, true)); }
DI float sum16(float v) {
  v += dpp_f<0xB1>(v);
  v += dpp_f<0x4E>(v);
  v += dpp_f<0x141>(v);
  v += dpp_f<0x140>(v);
  return v;
}
template <class B>
DI void epi_run(char* lds, const Acc8& acc, int nhalf, B body) {
  const int tid = threadIdx.x, lane = tid & 63, wid = tid >> 6, wr = wid >> 2, wc = wid & 3, fr = lane & 15, fq = lane >> 4;
  __syncthreads();
  dump_ai(lds, acc, 0, wr, wc, fr, fq);
  __syncthreads();
  body(0);
  if (nhalf > 1) {
    asm volatile("s_waitcnt lgkmcnt(0)" ::: "memory");
    __builtin_amdgcn_s_barrier();
    dump_ai(lds, acc, 1, wr, wc, fr, fq);
    __syncthreads();
    body(128);
  }
}
DI void reload_ai(const char* lds, Acc8& acc, int ai, int wr, int wc, int fr, int fq) {
  const char* base = lds + ((wr * 64 + fq * 4) * EPI_LD + wc * 32 + fr) * 4;
#pragma unroll
  for (int bj = 0; bj < 2; ++bj)
#pragma unroll
    for (int m = 0; m < 4; ++m)
#pragma unroll
      for (int n = 0; n < 2; ++n)
#pragma unroll
        for (int j = 0; j < 4; ++j) {
          const float x = *(const float*)(base + ((m * 16 + j) * EPI_LD + bj * 128 + n * 16) * 4);
          if (ai) acc[1][bj][m][n][j] = x; else acc[0][bj][m][n][j] = x;
        }
}
template <class B>
DI void acc_transform(char* lds, Acc8& acc, int nhalf, B body) {
  const int tid = threadIdx.x, lane = tid & 63, wid = tid >> 6, wr = wid >> 2, wc = wid & 3, fr = lane & 15, fq = lane >> 4;
  __syncthreads();
  dump_ai(lds, acc, 0, wr, wc, fr, fq);
  __syncthreads();
  body(0);
  __syncthreads();
  reload_ai(lds, acc, 0, wr, wc, fr, fq);
  if (nhalf > 1) {
    __syncthreads();
    dump_ai(lds, acc, 1, wr, wc, fr, fq);
    __syncthreads();
    body(128);
    __syncthreads();
    reload_ai(lds, acc, 1, wr, wc, fr, fq);
  }
}
DI u16* krow_ptr(char* ws, int row) {
  if (row < NP) return (u16*)(ws + OFF_KP) + (size_t)row * 160;
  return (u16*)(ws + OFF_KS) + (size_t)(((row - NP) >> 4) * KSROWS + PAST + ((row - NP) & 15)) * 160;
}

DI bool tile_of(int r, int b, int nn  , int& mi, int& ni) {
  const int nsup = nn >> 2;
  const int xcd = (b >> 5) & 7, slot = b & 31;
  if (r < nsup) { mi = xcd * 8 + (slot & 7); ni = r * 4 + (slot >> 3); return true; }
  int idx = (r - nsup) * 256 + b;
  const int nrem = nn & 3;
  if (idx < 64 * nrem) { mi = idx & 63; ni = 4 * nsup + (idx >> 6); return true; }
  idx -= 64 * nrem;
  if (idx < nn) { mi = 64; ni = idx; return true; }
  return false;
}

#define BW_CTR 0
#define BW_CNT(x) (64 + 64 * (x))
#define BW_XSUB(x) (1024 + 64 * (x))
#define BW_XGEN(x) (2048 + 64 * (x))
#define BW_TOP 3072
#define BW_TOPGEN 3136
#define BW_MCNT 3200
DI unsigned bar_ld(unsigned* p) { return __hip_atomic_load(p, __ATOMIC_RELAXED, __HIP_MEMORY_SCOPE_AGENT); }
DI unsigned bar_add(unsigned* p, unsigned v) { return __hip_atomic_fetch_add(p, v, __ATOMIC_RELAXED, __HIP_MEMORY_SCOPE_AGENT); }
DI void bar_st(unsigned* p, unsigned v) { __hip_atomic_store(p, v, __ATOMIC_RELAXED, __HIP_MEMORY_SCOPE_AGENT); }
DI void grid_barrier_xcd(unsigned* bar, unsigned k, unsigned xcc, unsigned my_cnt, unsigned nx) {
  asm volatile("s_waitcnt vmcnt(0)" ::: "memory");
  __syncthreads();
  if (threadIdx.x == 0) {
    const unsigned old = bar_add(bar + BW_XSUB(xcc), 1u);
    if (old == k * my_cnt - 1u) {
      __builtin_amdgcn_fence(__ATOMIC_RELEASE, "agent");
      asm volatile("s_waitcnt vmcnt(0)" ::: "memory");
      const unsigned t = bar_add(bar + BW_TOP, 1u);
      if (t == k * nx - 1u) bar_st(bar + BW_TOPGEN, k);
      else while (bar_ld(bar + BW_TOPGEN) < k) __builtin_amdgcn_s_sleep(1);
      bar_st(bar + BW_XGEN(xcc), k);
    } else {
      while (bar_ld(bar + BW_XGEN(xcc)) < k) __builtin_amdgcn_s_sleep(1);
    }
    __builtin_amdgcn_fence(__ATOMIC_ACQUIRE, "agent");
    asm volatile("s_waitcnt vmcnt(0)" ::: "memory");
  }
  __syncthreads();
}
DI void grid_barrier(unsigned* ctr, unsigned target) {
  asm volatile("s_waitcnt vmcnt(0)" ::: "memory");
  __syncthreads();
  if (threadIdx.x == 0) {
    __builtin_amdgcn_fence(__ATOMIC_RELEASE, "agent");
    asm volatile("s_waitcnt vmcnt(0)" ::: "memory");
    __hip_atomic_fetch_add(ctr, 1u, __ATOMIC_RELAXED, __HIP_MEMORY_SCOPE_AGENT);
    while (__hip_atomic_load(ctr, __ATOMIC_RELAXED, __HIP_MEMORY_SCOPE_AGENT) < target) __builtin_amdgcn_s_sleep(2);
    __builtin_amdgcn_fence(__ATOMIC_ACQUIRE, "agent");
    asm volatile("s_waitcnt vmcnt(0)" ::: "memory");
  }
  __syncthreads();
}

DI void epi1(const Params& p, Acc8& acc, int row0, int col0, char* lds) {
  const int tid = get_tid(), lane = tid & 63, wave = tid >> 6, wr = wave >> 1, wc = wave & 1;
  const int l31 = lane & 31, h = lane >> 5;
  const int rowbase = row0 + wr * 32;
  const int nhalf = (row0 + 128 >= NR) ? 1 : 2;
  const int e = (col0 >> 7) + wc;
  char* wl = lds + (wr * 32 * EPI_LD + wc * 128) * 4;
  char* ws = p.ws;
  const float* rstdx = (const float*)(ws + OFF_RSTDX);
  {
    const int gwr = wave >> 2, fq = lane >> 4;
#pragma unroll
    for (int ai = 0; ai < 2; ++ai)
#pragma unroll
      for (int m = 0; m < 4; ++m) {
        float rs[4];
#pragma unroll
        for (int j = 0; j < 4; ++j) rs[j] = rstdx[row0 + ai * 128 + gwr * 64 + m * 16 + fq * 4 + j];
#pragma unroll
        for (int bj = 0; bj < 2; ++bj)
#pragma unroll
          for (int n = 0; n < 2; ++n)
#pragma unroll
            for (int j = 0; j < 4; ++j) acc[ai][bj][m][n][j] *= rs[j];
      }
  }
  if (e < 2 || (e >= 4 && e < 8) || e >= 24) {
    u16* dst; int ld, cb;
    if (e < 2) { dst = (u16*)(ws + OFF_QLAT); ld = 256; cb = e * 128; }
    else if (e < 8) { dst = (u16*)(ws + OFF_SG); ld = 512; cb = (e - 4) * 128; }
    else { dst = (u16*)(ws + (e < 32 ? OFF_SA : OFF_SB)); ld = 1024; cb = ((e - 24) & 7) * 128; }
    float* ssq = (float*)(ws + OFF_SSQQ);
    epi_run(lds, acc, nhalf, [&](int mb) {
#pragma unroll 2
      for (int it = 0; it < 8; ++it) {
        const int lr = it * 4 + (lane >> 4), ch = lane & 15;
        const int row = rowbase + mb + lr;
        float v[8];
        read8(wl, lr, ch * 8, v);
        if (e < 2) {
          float s = 0.f;
#pragma unroll
          for (int j = 0; j < 8; ++j) s += v[j] * v[j];
          s = sum16(s);
          if (ch == 0) atomicAdd(&ssq[row], s);
        } else if (e < 8) {
#pragma unroll
          for (int j = 0; j < 8; ++j) v[j] = silu_f(v[j]);
        } else {
#pragma unroll
          for (int j = 0; j < 8; ++j) v[j] = sigm_f(v[j]);
        }
        *(u32x4*)(dst + (size_t)row * ld + cb + ch * 8) = pack8v(v);
      }
    });
  } else if (e == 2) {
    const float* kvg = p.in[9];
    epi_run(lds, acc, nhalf, [&](int mb) {
#pragma unroll 2
      for (int it = 0; it < 8; ++it) {
        const int lr = it * 4 + (lane >> 4), ch = lane & 15;
        const int row = rowbase + mb + lr;
        float v[8];
        read8(wl, lr, ch * 8, v);
        float s = 0.f;
#pragma unroll
        for (int j = 0; j < 8; ++j) s += v[j] * v[j];
        s = sum16(s);
        const float rk = rsqrtf(s * (1.f / 128.f) + EPS);
        const f32x4 g0 = *(const f32x4*)(kvg + ch * 8), g1 = *(const f32x4*)(kvg + ch * 8 + 4);
#pragma unroll
        for (int j = 0; j < 4; ++j) { v[j] *= rk * g0[j]; v[4 + j] *= rk * g1[j]; }
        if (row < NR) {
          float* o = (row < NP ? p.out + O_CKVP + (size_t)row * 128 : p.out + O_CKVS + (size_t)(row - NP) * 128) + ch * 8;
          f32x4 o0 = {v[0], v[1], v[2], v[3]}, o1 = {v[4], v[5], v[6], v[7]};
          *(f32x4*)o = o0;
          *(f32x4*)(o + 4) = o1;
          *(u32x4*)(krow_ptr(ws, row) + ch * 8) = pack8v(v);
        }
      }
    });
  } else if (e == 3) {
    epi_run(lds, acc, nhalf, [&](int mb) {
      const int lr = lane >> 1, hf = lane & 1;
      const int row = rowbase + mb + lr;
      float x1[8], x2[8], o1[8], o2[8];
      read8(wl, lr, hf * 8, x1);
      read8(wl, lr, 16 + hf * 8, x2);
      const float* tb = (const float*)(ws + OFF_ROPE) + row_pos(row) * 32 + hf * 8;
      float cc[8], sn[8];
      { const f32x4 t0 = *(const f32x4*)tb, t1 = *(const f32x4*)(tb + 4), t2 = *(const f32x4*)(tb + 16), t3 = *(const f32x4*)(tb + 20);
#pragma unroll
        for (int j = 0; j < 4; ++j) { cc[j] = t0[j]; cc[4 + j] = t1[j]; sn[j] = t2[j]; sn[4 + j] = t3[j]; } }
#pragma unroll
      for (int j = 0; j < 8; ++j) {
        const float a = x1[j], b = x2[j];
        o1[j] = a * cc[j] - b * sn[j];
        o2[j] = b * cc[j] + a * sn[j];
      }
      if (row < NR) {
        float* o = (row < NP ? p.out + O_KPEP + (size_t)row * 32 : p.out + O_KPES + (size_t)(row - NP) * 32) + hf * 8;
        f32x4 a0 = {o1[0], o1[1], o1[2], o1[3]}, a1 = {o1[4], o1[5], o1[6], o1[7]};
        f32x4 b0 = {o2[0], o2[1], o2[2], o2[3]}, b1 = {o2[4], o2[5], o2[6], o2[7]};
        *(f32x4*)o = a0; *(f32x4*)(o + 4) = a1;
        *(f32x4*)(o + 16) = b0; *(f32x4*)(o + 20) = b1;
        u16* k = krow_ptr(ws, row) + 128 + hf * 8;
        *(u32x4*)k = pack8v(o1);
        *(u32x4*)(k + 16) = pack8v(o2);
      }
    });
  } else {
    const int g = e - 8;
    u16* U = (u16*)(ws + OFF_U);
    u16* V = (u16*)(ws + OFF_V);
    u16* CB = (u16*)(ws + OFF_CB);
    const float* cw = p.in[13];
    const bool fused = row0 < NP;
    float* side = (float*)(lds + SIDE_OFF);
    const char* strip = lds + (wc * 128) * 4;
    epi_run(lds, acc, nhalf, [&](int mb) {
#pragma unroll 1
      for (int it = 0; it < 2; ++it) {
        const int lr = it * 16 + (lane >> 2), sub = lane & 3;
        const int hr = wr * 32 + lr;
        const int row = rowbase + mb + lr;
        float vb[8], vc[8], vx[8], vg[8], u[8], vv[8];
        read8(wl, lr, sub * 8, vb);
        read8(wl, lr, 32 + sub * 8, vc);
        read8(wl, lr, 64 + sub * 8, vx);
        read8(wl, lr, 96 + sub * 8, vg);
#pragma unroll
        for (int j = 0; j < 8; ++j) {
          u[j] = vc[j] * vx[j];
          vv[j] = vb[j] * silu_f(vg[j]);
        }
        const size_t o = (size_t)row * 512 + g * 32 + sub * 8;
        const int r256 = row & 255;
        if (!fused || r256 < 2 || r256 >= 254) {
          *(u32x4*)(U + o) = pack8v(u);
          *(u32x4*)(V + o) = pack8v(vv);
        }
        if (fused) {
          if (mb == 0 && hr >= 126) {
#pragma unroll
            for (int j = 0; j < 8; ++j) side[(hr - 126) * 64 + wc * 32 + sub * 8 + j] = u[j];
          }
          if (hr >= 2 || mb == 128) {
            float u1[8], u2[8];
            if (hr >= 1) {
              float c1[8], x1[8];
              read8(strip, hr - 1, 32 + sub * 8, c1);
              read8(strip, hr - 1, 64 + sub * 8, x1);
#pragma unroll
              for (int j = 0; j < 8; ++j) u1[j] = c1[j] * x1[j];
            } else {
#pragma unroll
              for (int j = 0; j < 8; ++j) u1[j] = side[64 + wc * 32 + sub * 8 + j];
            }
            if (hr >= 2) {
              float c2[8], x2[8];
              read8(strip, hr - 2, 32 + sub * 8, c2);
              read8(strip, hr - 2, 64 + sub * 8, x2);
#pragma unroll
              for (int j = 0; j < 8; ++j) u2[j] = c2[j] * x2[j];
            } else {
#pragma unroll
              for (int j = 0; j < 8; ++j) u2[j] = side[hr * 64 + wc * 32 + sub * 8 + j];
            }
            const float* w = cw + g * 32 + sub * 8;
            float r[8];
#pragma unroll
            for (int j = 0; j < 8; ++j) r[j] = vv[j] * (w[j] * u2[j] + w[512 + j] * u1[j] + w[1024 + j] * u[j]);
            *(u32x4*)(CB + o) = pack8v(r);
          }
        }
        float* cs = nullptr;
        if (row < NP) {
          const int t = row & (SEQ - 1);
          if (t >= SEQ - 2) cs = p.out + O_CONVP + (size_t)((row >> 13) * 2 + (t - (SEQ - 2))) * 512;
        } else if (row < NR) {
          const int t = (row - NP) & 15;
          if (t >= DSEQ - 2) cs = p.out + O_CONVS + (size_t)(((row - NP) >> 4) * 2 + (t - (DSEQ - 2))) * 512;
        }
        if (cs) {
          f32x4 a0 = {u[0], u[1], u[2], u[3]}, a1 = {u[4], u[5], u[6], u[7]};
          *(f32x4*)(cs + g * 32 + sub * 8) = a0;
          *(f32x4*)(cs + g * 32 + sub * 8 + 4) = a1;
        }
      }
    });
  }
}

DI void phase1(const Params& p, char* lds, int vb) {
  const u16* xb = (const u16*)(p.ws + OFF_XB);
  const u16* win = (const u16*)(p.ws + OFF_WIN);
  for (int r = 0;; ++r) {
    int mi, ni;
    if (!tile_of(r, vb, 20, mi, ni)) break;
    Acc8 acc;
    zero_acc(acc);
    gemm_main(xb, 1024, win, 1024, 1024, mi * 256, ni * 256, lds, acc);
    epi1(p, acc, mi * 256, ni * 256, lds);
  }
  if (gridDim.x > 40) {
    if (vb >= 20) prep_late(p, (vb - 20) * 512 + get_tid(), ((int)gridDim.x - 20) * 512);
  } else {
    prep_late(p, blockIdx.x * 512 + get_tid(), gridDim.x * 512);
  }
}

DI void phase2(const Params& p, char* lds, int vb) {
  const int tid = get_tid(), lane = tid & 63, wave = tid >> 6, wr = wave >> 1, wc = wave & 1;
  const int l31 = lane & 31, h = lane >> 5;
  char* ws = p.ws;
  const u16* ql = (const u16*)(ws + OFF_QLAT);
  const u16* wq = (const u16*)(ws + OFF_WQ);
  const float* ssq = (const float*)(ws + OFF_SSQQ);
  u16* qp = (u16*)(ws + OFF_QP);
  char* wl = lds + (wr * 32 * EPI_LD + wc * 128) * 4;
  for (int r = 0; r < 2; ++r) {
    int row0, col0;
    bool halfu = false;
    if (r == 0) {
      int mi, ni;
      if (!tile_of(0, vb, 5, mi, ni)) break;
      row0 = mi * 256; col0 = ni * 256;
    } else if (vb < 128) {
      row0 = vb * 128; col0 = 4 * 256; halfu = true;
    } else if (vb < 133) {
      row0 = 64 * 256; col0 = (vb - 128) * 256;
    } else break;
    Acc8 acc;
    zero_acc(acc);
    gemm_main(ql, 256, wq, 256, 256, row0, col0, lds, acc, halfu);
    const int rowbase = row0 + wr * 32;
    const int colbase = col0 + wc * 128;
    epi_run(lds, acc, (halfu || row0 + 128 >= NR) ? 1 : 2, [&](int mb) {
#pragma unroll 2
      for (int it = 0; it < 8; ++it) {
        const int lr = it * 4 + (lane >> 4), ch = lane & 15;
        const int row = rowbase + mb + lr;
        const float r = rsqrtf(ssq[row] * (1.f / 256.f) + EPS);
        float v[8], o[8];
        read8(wl, lr, ch * 8, v);
#pragma unroll
        for (int j = 0; j < 8; ++j) { v[j] *= r; o[j] = dpp_f<0x4E>(v[j]); }
        const int gt = (colbase >> 5) + (ch >> 2);
        if (gt % 5 == 4) {
          const int sub = ch & 3;
          const float* tb = (const float*)(ws + OFF_ROPE) + row_pos(row) * 32 + (sub & 1) * 8;
          const f32x4 t0 = *(const f32x4*)tb, t1 = *(const f32x4*)(tb + 4), t2 = *(const f32x4*)(tb + 16), t3 = *(const f32x4*)(tb + 20);
          const float sg = sub < 2 ? -1.f : 1.f;
#pragma unroll
          for (int j = 0; j < 4; ++j) {
            v[j] = v[j] * t0[j] + sg * o[j] * t2[j];
            v[4 + j] = v[4 + j] * t1[j] + sg * o[4 + j] * t3[j];
          }
        }
        *(u32x4*)(qp + (size_t)row * 1280 + colbase + ch * 8) = pack8v(v);
      }
    });
  }
  {
    const u16* U = (const u16*)(ws + OFF_U);
    const u16* V = (const u16*)(ws + OFF_V);
    u16* cb = (u16*)(ws + OFF_CB);
    const float* cw = p.in[13];
    const float* st = p.in[4];
    const bool part = gridDim.x > 160;
    const int gtid = part ? (vb - 133) * 512 + tid : (int)blockIdx.x * 512 + tid, nth = part ? ((int)gridDim.x - 133) * 512 : (int)gridDim.x * 512;
    if (!part || vb >= 133)
    for (int idx = gtid; idx < 256 * 64; idx += nth) {
      const int ri = idx >> 6, c8 = (idx & 63) * 8;
      const int row = ri < 128 ? (ri >> 1) * 256 + (ri & 1) : NP + (ri - 128);
      const u32x4 vv = *(const u32x4*)(V + (size_t)row * 512 + c8);
      const u32x4 u0 = *(const u32x4*)(U + (size_t)row * 512 + c8);
      float u1[8], u2[8];
      int t; const float* s0 = nullptr;
      if (row < NP) t = row & (SEQ - 1);
      else { t = (row - NP) & 15; s0 = st + (size_t)((row - NP) >> 4) * 1024 + c8; }
      if (t >= 1) {
        const u32x4 q = *(const u32x4*)(U + (size_t)(row - 1) * 512 + c8);
#pragma unroll
        for (int j = 0; j < 4; ++j) { u1[2 * j] = bf2f((u16)(q[j] & 0xffff)); u1[2 * j + 1] = bf2f((u16)(q[j] >> 16)); }
      } else {
#pragma unroll
        for (int j = 0; j < 8; ++j) u1[j] = s0 ? s0[512 + j] : 0.f;
      }
      if (t >= 2) {
        const u32x4 q = *(const u32x4*)(U + (size_t)(row - 2) * 512 + c8);
#pragma unroll
        for (int j = 0; j < 4; ++j) { u2[2 * j] = bf2f((u16)(q[j] & 0xffff)); u2[2 * j + 1] = bf2f((u16)(q[j] >> 16)); }
      } else {
#pragma unroll
        for (int j = 0; j < 8; ++j) u2[j] = s0 ? s0[(t == 0 ? 0 : 512) + j] : 0.f;
      }
      float r[8];
#pragma unroll
      for (int j = 0; j < 8; ++j) {
        const float uu = bf2f((u16)((j & 1) ? (u0[j >> 1] >> 16) : (u0[j >> 1] & 0xffff)));
        const float vj = bf2f((u16)((j & 1) ? (vv[j >> 1] >> 16) : (vv[j >> 1] & 0xffff)));
        r[j] = vj * (cw[c8 + j] * u2[j] + cw[512 + c8 + j] * u1[j] + cw[1024 + c8 + j] * uu);
      }
      *(u32x4*)(cb + (size_t)row * 512 + c8) = pack8(r[0], r[1], r[2], r[3], r[4], r[5], r[6], r[7]);
    }
  }
}

DI void attn_item(const Params& p, char* lds, const u16* __restrict__ Kbase, int nkt, int last_valid, size_t qrow0, int qmask, int nq) {
  const int tid = get_tid(), lane = tid & 63, head = tid >> 6;
  const int l31 = lane & 31, h = lane >> 5;
  char* ws = p.ws;
  const size_t R = qrow0 + (size_t)(l31 & qmask);
  const u16* qsrc = (const u16*)(ws + OFF_QP) + R * 1280 + head * 160 + 8 * h;
  bf16x8 qf[10];
#pragma unroll
  for (int s = 0; s < 10; ++s) qf[s] = *(const bf16x8*)(qsrc + 16 * s);
  f32x16 O[4];
#pragma unroll
  for (int dt = 0; dt < 4; ++dt)
#pragma unroll
    for (int i = 0; i < 16; ++i) O[dt][i] = 0.f;
  float m = -1e30f, l = 0.f;
  const int r0 = tid >> 4, c0 = (tid & 15) ^ (((r0 & 3) << 2) | ((r0 >> 2) & 3));
  const int rr = (tid >> 2) & 63, rc = (tid & 3) ^ ((rr >> 2) & 3);
  const u16* g0 = Kbase + (size_t)r0 * 160 + c0 * 8;
  const u16* gr = Kbase + (size_t)rr * 160 + 128 + rc * 8;
  char* sdst = lds + tid * 16;
#define LDSP(x) ((__attribute__((address_space(3))) unsigned*)(x))
  __syncthreads();
  __builtin_amdgcn_global_load_lds((const unsigned*)g0, LDSP(sdst), 16, 0, 0);
  __builtin_amdgcn_global_load_lds((const unsigned*)(g0 + 32 * 160), LDSP(sdst + 8192), 16, 0, 0);
  if (tid < 256) __builtin_amdgcn_global_load_lds((const unsigned*)gr, LDSP(sdst + 16384), 16, 0, 0);
  asm volatile("s_waitcnt vmcnt(0)" ::: "memory");
  __syncthreads();
  const int kkey = ((l31 & 3) << 2) | ((l31 >> 2) & 3);
  const int krow = 256 * l31;
  const int rkey = (l31 >> 2) & 3;
  const int rrow = 16384 + 64 * l31;
  const int qq = (lane & 15) >> 2, pp = lane & 3, blk = (lane >> 4) & 1, cl = 2 * blk + (pp >> 1);
  unsigned va[2][4];
#pragma unroll
  for (int t = 0; t < 2; ++t)
#pragma unroll
    for (int dt = 0; dt < 4; ++dt)
      va[t][dt] = 256 * (8 * t + 4 * h + qq) + 64 * (dt ^ qq) + 16 * (cl ^ ((2 * t + h) & 3)) + 8 * (pp & 1);
  const unsigned ldsbase = (unsigned)(size_t)lds;
  for (int jt = 0; jt < nkt; ++jt) {
    const int cur = jt & 1;
    const bool more = jt + 1 < nkt;
    if (more) {
      const size_t go = (size_t)(jt + 1) * 64 * 160;
      char* wb = sdst + (cur ^ 1) * 20480;
      __builtin_amdgcn_global_load_lds((const unsigned*)(g0 + go), LDSP(wb), 16, 0, 0);
      __builtin_amdgcn_global_load_lds((const unsigned*)(g0 + go + 32 * 160), LDSP(wb + 8192), 16, 0, 0);
      if (tid < 256) __builtin_amdgcn_global_load_lds((const unsigned*)(gr + go), LDSP(wb + 16384), 16, 0, 0);
    }
    const char* kb = lds + cur * 20480;
    f32x16 S[2];
#pragma unroll
    for (int i = 0; i < 16; ++i) { S[0][i] = 0.f; S[1][i] = 0.f; }
    {
      bf16x8 ka[2][2];
#pragma unroll
      for (int kt2 = 0; kt2 < 2; ++kt2) ka[0][kt2] = *(const bf16x8*)(kb + krow + kt2 * 8192 + ((h ^ kkey) << 4));
#pragma unroll
      for (int s = 0; s < 10; ++s) {
        if (s + 1 < 8) {
          const int co = ((2 * (s + 1) + h) ^ kkey) << 4;
#pragma unroll
          for (int kt2 = 0; kt2 < 2; ++kt2) ka[(s + 1) & 1][kt2] = *(const bf16x8*)(kb + krow + kt2 * 8192 + co);
        } else if (s + 1 < 10) {
          const int co = ((2 * (s + 1 - 8) + h) ^ rkey) << 4;
#pragma unroll
          for (int kt2 = 0; kt2 < 2; ++kt2) ka[(s + 1) & 1][kt2] = *(const bf16x8*)(kb + rrow + kt2 * 2048 + co);
        }
#pragma unroll
        for (int kt2 = 0; kt2 < 2; ++kt2) S[kt2] = MFMA(ka[s & 1][kt2], qf[s], S[kt2]);
      }
    }
    if (!more && last_valid < 64) {
      const int thr = last_valid - 4 * h;
#pragma unroll
      for (int kt2 = 0; kt2 < 2; ++kt2)
#pragma unroll
        for (int i = 0; i < 16; ++i)
          if (kt2 * 32 + (i & 3) + 8 * (i >> 2) >= thr) S[kt2][i] = -1e30f;
    }
    float mx = S[0][0];
#pragma unroll
    for (int i = 1; i < 16; ++i) mx = fmaxf(mx, S[0][i]);
#pragma unroll
    for (int i = 0; i < 16; ++i) mx = fmaxf(mx, S[1][i]);
    {
      const auto sw = __builtin_amdgcn_permlane32_swap(__float_as_uint(mx), __float_as_uint(mx), false, false);
      mx = fmaxf(__uint_as_float(sw[0]), __uint_as_float(sw[1]));
    }
    const bool grow = __builtin_amdgcn_ballot_w64(mx > m + 2.f) != 0;
    const float mn = grow ? fmaxf(m, mx) : m;
    const float alpha = __builtin_amdgcn_exp2f(m - mn);
    m = mn;
    float ps = 0.f;
#pragma unroll
    for (int kt2 = 0; kt2 < 2; ++kt2)
#pragma unroll
      for (int i = 0; i < 16; ++i) {
        const float e = __builtin_amdgcn_exp2f(S[kt2][i] - mn);
        S[kt2][i] = e;
        ps += e;
      }
    l = l * alpha + ps;
    if (__builtin_amdgcn_ballot_w64(alpha != 1.f) != 0) {
#pragma unroll
      for (int dt = 0; dt < 4; ++dt)
#pragma unroll
        for (int i = 0; i < 16; ++i) O[dt][i] *= alpha;
    }
    unsigned vc[2][4];
#pragma unroll
    for (int t = 0; t < 2; ++t)
#pragma unroll
      for (int dt = 0; dt < 4; ++dt) vc[t][dt] = va[t][dt] + ldsbase + cur * 20480;
#pragma unroll
    for (int kt2 = 0; kt2 < 2; ++kt2)
#pragma unroll
      for (int s2 = 0; s2 < 2; ++s2) {
        const bf16x8 pf = pack_step(S[kt2], s2);
        s16x4 v00, v01, v02, v03, v10, v11, v12, v13;
        asm volatile(
            "ds_read_b64_tr_b16 %0, %8 offset:%16\n\t"
            "ds_read_b64_tr_b16 %1, %9 offset:%16\n\t"
            "ds_read_b64_tr_b16 %2, %10 offset:%16\n\t"
            "ds_read_b64_tr_b16 %3, %11 offset:%16\n\t"
            "ds_read_b64_tr_b16 %4, %12 offset:%16\n\t"
            "ds_read_b64_tr_b16 %5, %13 offset:%16\n\t"
            "ds_read_b64_tr_b16 %6, %14 offset:%16\n\t"
            "ds_read_b64_tr_b16 %7, %15 offset:%16\n\t"
            "s_waitcnt lgkmcnt(0)"
            : "=&v"(v00), "=&v"(v01), "=&v"(v02), "=&v"(v03), "=&v"(v10), "=&v"(v11), "=&v"(v12), "=&v"(v13)
            : "v"(vc[0][0]), "v"(vc[0][1]), "v"(vc[0][2]), "v"(vc[0][3]),
              "v"(vc[1][0]), "v"(vc[1][1]), "v"(vc[1][2]), "v"(vc[1][3]), "n"((kt2 * 32 + 16 * s2) * 256)
            : "memory");
        O[0] = MFMA(__builtin_shufflevector(v00, v10, 0, 1, 2, 3, 4, 5, 6, 7), pf, O[0]);
        O[1] = MFMA(__builtin_shufflevector(v01, v11, 0, 1, 2, 3, 4, 5, 6, 7), pf, O[1]);
        O[2] = MFMA(__builtin_shufflevector(v02, v12, 0, 1, 2, 3, 4, 5, 6, 7), pf, O[2]);
        O[3] = MFMA(__builtin_shufflevector(v03, v13, 0, 1, 2, 3, 4, 5, 6, 7), pf, O[3]);
      }
    asm volatile("s_waitcnt vmcnt(0)" ::: "memory");
    __syncthreads();
  }
  l += __shfl_xor(l, 32);
  const float inv = 1.f / l;
#pragma unroll
  for (int dt = 0; dt < 4; ++dt)
#pragma unroll
    for (int i = 0; i < 16; ++i) O[dt][i] *= inv;
  f32x16 o2[2];
#pragma unroll
  for (int i = 0; i < 16; ++i) { o2[0][i] = 0.f; o2[1][i] = 0.f; }
  const bf16x8* wf = (const bf16x8*)(ws + OFF_WUV) + (size_t)head * 16 * 64 + lane;
#pragma unroll
  for (int dt = 0; dt < 4; ++dt)
#pragma unroll
    for (int s2 = 0; s2 < 2; ++s2) {
      const bf16x8 b = pack_step(O[dt], s2);
#pragma unroll
      for (int mt = 0; mt < 2; ++mt) {
        const bf16x8 a = wf[((mt * 4 + dt) * 2 + s2) * 64];
        o2[mt] = MFMA(a, b, o2[mt]);
      }
    }
  if (l31 < nq) {
    const u16* sg = (const u16*)(ws + OFF_SG) + R * 512 + head * 64 + 4 * h;
    u16* og = (u16*)(ws + OFF_U) + R * 512 + head * 64 + 4 * h;
#pragma unroll
    for (int mt = 0; mt < 2; ++mt)
#pragma unroll
      for (int g4 = 0; g4 < 4; ++g4) {
        const u32x2 gv = *(const u32x2*)(sg + mt * 32 + 8 * g4);
        const float a0 = o2[mt][4 * g4 + 0] * bf2f((u16)(gv[0] & 0xffff));
        const float a1 = o2[mt][4 * g4 + 1] * bf2f((u16)(gv[0] >> 16));
        const float a2 = o2[mt][4 * g4 + 2] * bf2f((u16)(gv[1] & 0xffff));
        const float a3 = o2[mt][4 * g4 + 3] * bf2f((u16)(gv[1] >> 16));
        u32x2 ov = {pack2(a0, a1), pack2(a2, a3)};
        *(u32x2*)(og + mt * 32 + 8 * g4) = ov;
      }
  }
}

DI void phase3(const Params& p, char* lds) {
  const u16* kp = (const u16*)(p.ws + OFF_KP);
  const u16* ks = (const u16*)(p.ws + OFF_KS);
  const int nb = gridDim.x;
#pragma unroll 1
  for (int j = 0;; ++j) {
    int id;
    if (nb == 256) { if (j >= 4) break; id = p.sched[blockIdx.x][j]; if (id < 0) break; }
    else { id = blockIdx.x + j * nb; if (id >= 520) break; }
    const u16* kb; int nkt, lastv, qmask, nq; size_t q0;
    if (id < 512) {
      const int b = id >> 8, hc = id & 255;
      kb = kp + (size_t)b * SEQ * 160; nkt = (hc >> 1) + 1; lastv = 64; q0 = (size_t)b * SEQ + hc * 32; qmask = 31; nq = 32;
    } else {
      const int b = id - 512;
      kb = ks + (size_t)b * KSROWS * 160; nkt = 17; lastv = 16; q0 = (size_t)NP + b * 16; qmask = 15; nq = 16;
    }
    attn_item(p, lds, kb, nkt, lastv, q0, qmask, nq);
  }
}

DI void unpack8(const u32x4 q, float (&f)[8]) {
#pragma unroll
  for (int j = 0; j < 4; ++j) { f[2 * j] = bf2f((u16)(q[j] & 0xffff)); f[2 * j + 1] = bf2f((u16)(q[j] >> 16)); }
}
DI void phase4a(const Params& p, char* lds, int vb) {
  const int tid = get_tid(), lane = tid & 63, wave = tid >> 6, wr = wave >> 1, wc = wave & 1;
  const int l31 = lane & 31, h = lane >> 5;
  char* ws = p.ws;
  const u16* og = (const u16*)(ws + OFF_U);
  const u16* cb = (const u16*)(ws + OFF_CB);
  const u16* woa = (const u16*)(ws + OFF_WOA);
  const u16* wob = (const u16*)(ws + OFF_WOB);
  const u16* sa = (const u16*)(ws + OFF_SA);
  const u16* sb = (const u16*)(ws + OFF_SB);
  u16* mg = (u16*)(ws + OFF_XB);
  char* wl = lds + (wr * 32 * EPI_LD + wc * 128) * 4;
  for (int r = 0;; ++r) {
    int mi, ni;
    if (!tile_of(r, vb, 4, mi, ni)) break;
    const int row0 = mi * 256, col0 = ni * 256;
    const int rowbase = row0 + wr * 32, colbase = col0 + wc * 128;
    const int nhalf = (row0 + 128 >= NR) ? 1 : 2;
    Acc8 acc;
    zero_acc(acc);
#pragma unroll 1
    for (int pass = 0; pass < 2; ++pass) {
      gemm_main(pass ? cb : og, 512, pass ? wob : woa, 512, 512, row0, col0, lds, acc);
      if (pass == 0) {
        acc_transform(lds, acc, nhalf, [&](int mb) {
#pragma unroll 2
          for (int it = 0; it < 8; ++it) {
            const int lr = it * 4 + (lane >> 4), ch = lane & 15;
            const size_t o = (size_t)(rowbase + mb + lr) * 1024 + colbase + ch * 8;
            float v[8], ga[8], gb[8];
            read8(wl, lr, ch * 8, v);
            unpack8(*(const u32x4*)(sa + o), ga);
            unpack8(*(const u32x4*)(sb + o), gb);
#pragma unroll
            for (int j = 0; j < 8; ++j) v[j] *= ga[j] * __builtin_amdgcn_rcpf(fmaxf(gb[j], 1e-30f));
            const f32x4 w0 = {v[0], v[1], v[2], v[3]}, w1 = {v[4], v[5], v[6], v[7]};
            *(f32x4*)(wl + (lr * EPI_LD + ch * 8) * 4) = w0;
            *(f32x4*)(wl + (lr * EPI_LD + ch * 8) * 4 + 16) = w1;
          }
        });
      } else {
        epi_run(lds, acc, nhalf, [&](int mb) {
#pragma unroll 2
          for (int it = 0; it < 8; ++it) {
            const int lr = it * 4 + (lane >> 4), ch = lane & 15;
            const size_t o = (size_t)(rowbase + mb + lr) * 1024 + colbase + ch * 8;
            float v[8], gb[8];
            read8(wl, lr, ch * 8, v);
            unpack8(*(const u32x4*)(sb + o), gb);
#pragma unroll
            for (int j = 0; j < 8; ++j) v[j] *= fmaxf(gb[j], 1e-30f);
            *(u32x4*)(mg + o) = pack8v(v);
          }
        });
      }
    }
  }
}

DI void phase4b(const Params& p, char* lds, int vb) {
  const int tid = get_tid(), lane = tid & 63, wave = tid >> 6, wr = wave >> 1, wc = wave & 1;
  const int l31 = lane & 31, h = lane >> 5;
  char* ws = p.ws;
  const u16* mg = (const u16*)(ws + OFF_XB);
  const u16* wo = (const u16*)(ws + OFF_WOUT);
  u16* z = (u16*)(ws + OFF_QP);
  float* ssq = (float*)(ws + OFF_SSQZ);
  char* wl = lds + (wr * 32 * EPI_LD + wc * 128) * 4;
  for (int r = 0; r < 1; ++r) {
    int mi, ni;
    if (!tile_of(r, vb, 4, mi, ni)) break;
    const int row0 = mi * 256, col0 = ni * 256;
    const int rowbase = row0 + wr * 32, colbase = col0 + wc * 128;
    Acc8 acc;
    zero_acc(acc);
    gemm_main(mg, 1024, wo, 1024, 1024, row0, col0, lds, acc);
    epi_run(lds, acc, 2, [&](int mb) {
#pragma unroll 2
      for (int it = 0; it < 8; ++it) {
        const int lr = it * 4 + (lane >> 4), ch = lane & 15;
        const int row = rowbase + mb + lr;
        float v[8];
        read8(wl, lr, ch * 8, v);
        float s = 0.f;
#pragma unroll
        for (int j = 0; j < 8; ++j) s += v[j] * v[j];
        s = sum16(s);
        if (ch == 0) atomicAdd(&ssq[row], s);
      }
    });
    asm volatile("s_waitcnt vmcnt(0)" ::: "memory");
    __syncthreads();
    if (threadIdx.x == 0) {
      unsigned* c = (unsigned*)(ws + OFF_BAR) + BW_MCNT + mi;
      bar_add(c, 1u);
      while (bar_ld(c) < 4u) __builtin_amdgcn_s_sleep(1);
    }
    __syncthreads();
    const float* pg = p.in[16];
    epi_run(lds, acc, 2, [&](int mb) {
#pragma unroll 2
      for (int it = 0; it < 8; ++it) {
        const int lr = it * 4 + (lane >> 4), ch = lane & 15;
        const int row = rowbase + mb + lr;
        const int col = colbase + ch * 8;
        float v[8];
        read8(wl, lr, ch * 8, v);
        const float r = rsqrtf(__hip_atomic_load(&ssq[row], __ATOMIC_RELAXED, __HIP_MEMORY_SCOPE_AGENT) * (1.f / 1024.f) + EPS);
        const float* xs = p.in[0] + (size_t)row * 1024 + col;
        const f32x4 x0 = *(const f32x4*)xs, x1 = *(const f32x4*)(xs + 4);
        const f32x4 g0 = *(const f32x4*)(pg + col), g1 = *(const f32x4*)(pg + col + 4);
        f32x4 y0, y1;
#pragma unroll
        for (int j = 0; j < 4; ++j) { y0[j] = x0[j] + v[j] * r * g0[j]; y1[j] = x1[j] + v[4 + j] * r * g1[j]; }
        float* yd = p.out + O_YP + (size_t)row * 1024 + col;
        *(f32x4*)yd = y0;
        *(f32x4*)(yd + 4) = y1;
      }
    });
  }
  if (vb < 16) {
    const int ni = vb >> 2, ks = vb & 3;
    Acc8 acc;
    zero_acc(acc);
    gemm_main(mg + ks * 256, 1024, wo + ks * 256, 1024, 256, 64 * 256, ni * 256, lds, acc);
    float* zs = (float*)(ws + OFF_ZS);
    const int gwr = wave >> 2, gwc = wave & 3, fr = lane & 15, fq = lane >> 4;
#pragma unroll
    for (int bj = 0; bj < 2; ++bj)
#pragma unroll
      for (int m = 0; m < 4; ++m)
#pragma unroll
        for (int n = 0; n < 2; ++n)
#pragma unroll
          for (int j = 0; j < 4; ++j)
            atomicAdd(&zs[(size_t)(gwr * 64 + m * 16 + fq * 4 + j) * 1024 + ni * 256 + bj * 128 + gwc * 32 + n * 16 + fr], acc[0][bj][m][n][j]);
  }
}

DI void phase5(const Params& p) {
  const int tid = get_tid(), lane = tid & 63, wave = tid >> 6;
  const int gtid = blockIdx.x * 512 + tid, nth = gridDim.x * 512;
  const u16* z = (const u16*)(p.ws + OFF_QP);
  const float* ssq = (const float*)(p.ws + OFF_SSQZ);
  const float* pg = p.in[16];
  const float* zs = (const float*)(p.ws + OFF_ZS);
  for (int srow = blockIdx.x * 8 + wave; srow < NS; srow += gridDim.x * 8) {
    f32x4 v[4];
    float ss = 0.f;
#pragma unroll
    for (int i = 0; i < 4; ++i) {
      v[i] = *(const f32x4*)(zs + (size_t)srow * 1024 + (i * 64 + lane) * 4);
      ss += v[i][0] * v[i][0] + v[i][1] * v[i][1] + v[i][2] * v[i][2] + v[i][3] * v[i][3];
    }
    ss = wave_sum(ss);
    const float r = rsqrtf(ss * (1.f / 1024.f) + EPS);
#pragma unroll
    for (int i = 0; i < 4; ++i) {
      const int c4 = (i * 64 + lane) * 4;
      const f32x4 x = *(const f32x4*)(p.in[1] + (size_t)srow * 1024 + c4);
      const f32x4 g = *(const f32x4*)(pg + c4);
      f32x4 y;
#pragma unroll
      for (int j = 0; j < 4; ++j) y[j] = x[j] + v[i][j] * r * g[j];
      *(f32x4*)(p.out + O_YS + (size_t)srow * 1024 + c4) = y;
    }
  }
}

template <int PH>
DI void run_phase(const Params& p, char* lds, int vb) {
  if constexpr (PH == 0) phase0(p);
  else if constexpr (PH == 1) phase1(p, lds, vb);
  else if constexpr (PH == 2) phase2(p, lds, vb);
  else if constexpr (PH == 3) phase3(p, lds);
  else if constexpr (PH == 4) phase4a(p, lds, vb);
  else if constexpr (PH == 5) phase4b(p, lds, vb);
  else phase5(p);
}

template <int PH>
__global__ void __launch_bounds__(512) fwd_kernel(Params p) {
  extern __shared__ __attribute__((aligned(16))) char lds[];
  if constexpr (PH >= 0) {
    run_phase<PH>(p, lds, (int)blockIdx.x);
  } else {
    unsigned* bar = (unsigned*)(p.ws + OFF_BAR);
    const unsigned nb = gridDim.x;
    if (p.ph_hi < 0) cg::this_grid().sync();
    const unsigned xcc = (unsigned)__builtin_amdgcn_s_getreg((3 << 11) | 20) & 7u;
    if (threadIdx.x == 0) *(unsigned*)lds = bar_add(bar + BW_CNT(xcc), 1u);
    __syncthreads();
    const unsigned slot = (unsigned)__builtin_amdgcn_readfirstlane((int)*(volatile unsigned*)lds);
    __syncthreads();
    run_phase<0>(p, lds, 0);
    if (threadIdx.x == 0) {
      unsigned tot;
      do {
        tot = 0;
        for (unsigned x = 0; x < 8; ++x) tot += bar_ld(bar + BW_CNT(x));
        if (tot < nb) __builtin_amdgcn_s_sleep(1);
      } while (tot < nb);
    }
    __syncthreads();
    unsigned vbu = slot, my_cnt = 0, nx = 0;
    for (unsigned x = 0; x < 8; ++x) {
      const unsigned c = bar_ld(bar + BW_CNT(x));
      if (x < xcc) vbu += c;
      if (x == xcc) my_cnt = c;
      nx += c ? 1u : 0u;
    }
    const int vb = __builtin_amdgcn_readfirstlane((int)vbu);
    my_cnt = (unsigned)__builtin_amdgcn_readfirstlane((int)my_cnt);
    nx = (unsigned)__builtin_amdgcn_readfirstlane((int)nx);
    grid_barrier_xcd(bar, 1, xcc, my_cnt, nx);
    run_phase<1>(p, lds, vb); grid_barrier_xcd(bar, 2, xcc, my_cnt, nx);
    run_phase<2>(p, lds, vb); grid_barrier_xcd(bar, 3, xcc, my_cnt, nx);
    run_phase<3>(p, lds, vb); grid_barrier_xcd(bar, 4, xcc, my_cnt, nx);
    run_phase<4>(p, lds, vb); grid_barrier_xcd(bar, 5, xcc, my_cnt, nx);
    run_phase<5>(p, lds, vb); grid_barrier_xcd(bar, 6, xcc, my_cnt, nx);
    run_phase<6>(p, lds, vb);
  }
}

template <int PH>
static void launch_phase(const Params& p, int grid, hipStream_t stream) {
  static bool attr_set = false;
  if (!attr_set) {
    if (hipFuncSetAttribute((const void*)fwd_kernel<PH>, hipFuncAttributeMaxDynamicSharedMemorySize, LDS_BYTES) != hipSuccess)
      fprintf(stderr, "kernel_launch: hipFuncSetAttribute failed (phase %d)\n", PH);
    attr_set = true;
  }
  hipLaunchKernelGGL(fwd_kernel<PH>, dim3(grid), dim3(512), LDS_BYTES, stream, p);
}

extern "C" void kernel_launch(void* const* d_in, const int* in_sizes, int n_in, void* d_out, int out_size, void* d_ws,
                              size_t ws_size, hipStream_t stream) {
  static int grid = 0;
  if (grid == 0) {
    if (n_in != 17 || ws_size < WS_END) {
      fprintf(stderr, "kernel_launch: unexpected n_in %d or ws_size %zu (< %zu)\n", n_in, ws_size, (size_t)WS_END);
      grid = -1;
      return;
    }
    int dev = 0, cus = 0;
    (void)hipGetDevice(&dev);
    (void)hipDeviceGetAttribute(&cus, hipDeviceAttributeMultiprocessorCount, dev);
#if ONE_LAUNCH
    int per_cu = 0;
    if (hipFuncSetAttribute((const void*)fwd_kernel<-1>, hipFuncAttributeMaxDynamicSharedMemorySize, LDS_BYTES) != hipSuccess)
      fprintf(stderr, "kernel_launch: hipFuncSetAttribute failed\n");
    (void)hipOccupancyMaxActiveBlocksPerMultiprocessor(&per_cu, (const void*)fwd_kernel<-1>, 512, LDS_BYTES);
    if (per_cu < 1) fprintf(stderr, "kernel_launch: occupancy query says %d blocks/CU\n", per_cu);
    (void)hipGetLastError();
#endif
    grid = cus;
  }
  if (grid < 0) return;
  Params p{};
  {
    int load[256] = {0}, cnt[256] = {0};
    for (int b = 0; b < 256; ++b) for (int j = 0; j < 4; ++j) p.sched[b][j] = -1;
    auto place = [&](int id, int cost) {
      int best = -1;
      for (int b = 0; b < 256; ++b) if (cnt[b] < 4 && (best < 0 || load[b] < load[best])) best = b;
      p.sched[best][cnt[best]++] = (short)id;
      load[best] += cost + 3;
    };
    for (int cost = 128; cost >= 1; --cost) {
      if (cost == 17) for (int s = 0; s < 8; ++s) place(512 + s, 17);
      const int c = cost - 1;
      for (int b = 0; b < 2; ++b) for (int hf = 0; hf < 2; ++hf) place(b * 256 + c * 2 + hf, cost);
    }
  }
  for (int i = 0; i < 17; ++i) p.in[i] = (const float*)d_in[i];
  p.out = (float*)d_out;
  p.ws = (char*)d_ws;
  p.ph_lo = 0;
  p.ph_hi = 7;
  (void)hipMemsetAsync((char*)d_ws + OFF_BAR, 0, BAR_BYTES, stream);
#if ONE_LAUNCH
  void* args[] = {&p};
  hipError_t e = hipLaunchCooperativeKernel((const void*)fwd_kernel<-1>, dim3(grid), dim3(512), args, LDS_BYTES, stream);
  if (e != hipSuccess) fprintf(stderr, "cooperative launch failed: %s (grid %d)\n", hipGetErrorString(e), grid);
#else
  launch_phase<0>(p, grid, stream);
  launch_phase<1>(p, grid, stream);
#if PROBE_REPEAT == 1
  launch_phase<0>(p, grid, stream);
  launch_phase<1>(p, grid, stream);
#endif
  launch_phase<2>(p, grid, stream);
#if PROBE_REPEAT == 2
  launch_phase<2>(p, grid, stream);
#endif
  launch_phase<3>(p, grid, stream);
#if PROBE_REPEAT == 3
  launch_phase<3>(p, grid, stream);
#endif
  launch_phase<4>(p, grid, stream);
#if PROBE_REPEAT == 4
  launch_phase<4>(p, grid, stream);
#endif
  launch_phase<5>(p, grid, stream);
  launch_phase<6>(p, grid, stream);
#endif
}
```
